# Optimizing an MI355X kernel written in HIP

```python
import math
import jax, jax.numpy as jnp
from jax import lax
import numpy as np


D_MODEL = 1024
BATCH = 2
SEQ = 8192
DEPTH = 1

N_MEM = 256
POOL_WINDOWS = (2, 4, 8, 16)
POOL_GROUPS = len(POOL_WINDOWS)
POOL_WIDTH = D_MODEL // 2
POOL_GROUP_DIM = POOL_WIDTH // POOL_GROUPS
DA_HEADS = 8
DA_QK_DIM = 64
DA_V_DIM = 2 * DA_QK_DIM
DA_WIDTH = DA_HEADS * DA_V_DIM
Q_BLOCK = 128
XA_HEADS = 4
XA_HEAD_DIM = D_MODEL // XA_HEADS
PEER_HEADS = 8
PEER_N_KEYS = 128
PEER_N_EXPERTS = PEER_N_KEYS * PEER_N_KEYS
PEER_QUERY_DIM = 128
PEER_HALF = PEER_QUERY_DIM // 2
PEER_TOPK = 16
PEER_TOKEN_BLOCK = 128
IN_SPLITS = (POOL_WIDTH, POOL_WIDTH + DA_WIDTH, POOL_WIDTH + 2 * DA_WIDTH,
             POOL_WIDTH + 3 * DA_WIDTH, POOL_WIDTH + 3 * DA_WIDTH + D_MODEL)
IN_WIDTH = POOL_WIDTH + 3 * DA_WIDTH + 2 * D_MODEL
DN_ALPHA = (2 * DEPTH) ** 0.25
DN_BETA = (8 * DEPTH) ** -0.25
LN_EPS = 1e-5
NEG_INF = -1e30

kernel_name = 'hybrid_pool_diffattn_peer_block'


def layer_norm(x, g, b):
    xf = x.astype(jnp.float32)
    mu = jnp.mean(xf, axis=-1, keepdims=True)
    var = jnp.mean(jnp.square(xf - mu), axis=-1, keepdims=True)
    y = (xf - mu) * lax.rsqrt(var + LN_EPS) * g.astype(jnp.float32) + b.astype(jnp.float32)
    return y.astype(x.dtype)


def alibi_slopes(n_heads):
    return jnp.exp2(-8.0 * jnp.arange(1, n_heads + 1, dtype=jnp.float32) / n_heads)


def causal_multiscale_pool(p):
    B_, S_, _ = p.shape
    pf = p.astype(jnp.float32).reshape(B_, S_, POOL_GROUPS, POOL_GROUP_DIM)
    csp = jnp.pad(lax.cumsum(pf, axis=1), ((0, 0), (1, 0), (0, 0), (0, 0)))
    pos = jnp.arange(1, S_ + 1, dtype=jnp.float32)
    outs = []
    for g, w in enumerate(POOL_WINDOWS):
        c = csp[:, :, g]
        lower = jnp.pad(c[:, :S_ - w + 1], ((0, 0), (w - 1, 0), (0, 0)))
        mean = (c[:, 1:] - lower) / jnp.minimum(pos, float(w))[None, :, None]
        outs.append(mean - pf[:, :, g])
    return jnp.stack(outs, axis=2).astype(p.dtype)


def diff_attention(q, k, v, lam, lam_init, subln_w):
    B_, S_, _ = q.shape
    nb = S_ // Q_BLOCK
    kh = k.reshape(B_, S_, DA_HEADS, 2, DA_QK_DIM)
    k1 = kh[:, :, :, 0].transpose(0, 2, 1, 3)
    k2 = kh[:, :, :, 1].transpose(0, 2, 1, 3)
    vh = v.reshape(B_, S_, DA_HEADS, DA_V_DIM).transpose(0, 2, 1, 3)
    qb = q.reshape(B_, nb, Q_BLOCK, DA_HEADS, 2, DA_QK_DIM).transpose(1, 0, 3, 4, 2, 5)
    slopes = alibi_slopes(DA_HEADS)
    kpos = jnp.arange(S_)
    scale = DA_QK_DIM ** -0.5

    def block(args):
        qblk, start = args
        qpos = start + jnp.arange(Q_BLOCK)
        dist = (qpos[:, None] - kpos[None, :]).astype(jnp.float32)
        bias = -slopes[:, None, None] * dist
        causal = dist >= 0

        def probs(qm, km):
            s = jnp.einsum('bhqd,bhkd->bhqk', qm, km).astype(jnp.float32) * scale + bias
            return jax.nn.softmax(jnp.where(causal, s, NEG_INF), axis=-1)

        a = probs(qblk[:, :, 0], k1) - lam * probs(qblk[:, :, 1], k2)
        return jnp.einsum('bhqk,bhkd->bhqd', a.astype(vh.dtype), vh)

    o = lax.map(block, (qb, jnp.arange(nb) * Q_BLOCK))
    of = o.astype(jnp.float32)
    of = of * lax.rsqrt(jnp.mean(jnp.square(of), axis=-1, keepdims=True) + LN_EPS)
    of = of * subln_w.astype(jnp.float32) * (1.0 - lam_init)
    return of.astype(v.dtype).transpose(1, 0, 3, 2, 4).reshape(B_, S_, DA_WIDTH)


def memory_cross_attention(x, mem, w_q, w_kv, w_o):
    B_, S_, _ = x.shape
    m = mem.shape[1]
    q = (x @ w_q).reshape(B_, S_, XA_HEADS, XA_HEAD_DIM)
    kv = (mem @ w_kv).reshape(B_, m, 2, XA_HEADS, XA_HEAD_DIM)
    s = jnp.einsum('bshd,bmhd->bhsm', q, kv[:, :, 0]).astype(jnp.float32) * (XA_HEAD_DIM ** -0.5)
    a = jax.nn.softmax(s, axis=-1)
    o = jnp.einsum('bhsm,bmhd->bshd', a.astype(x.dtype), kv[:, :, 1]).reshape(B_, S_, D_MODEL)
    return o @ w_o


def peer(x, w_q, sub_keys, expert_u, expert_v):
    B_, S_, D = x.shape
    t = x.reshape(-1, D)
    T = t.shape[0]
    q = (t @ w_q).reshape(T, PEER_HEADS, 2, PEER_HALF)
    s = jnp.einsum('thcd,hcnd->thcn', q, sub_keys).astype(jnp.float32)
    sv, si = lax.top_k(s, PEER_TOPK)
    cand = (sv[:, :, 0, :, None] + sv[:, :, 1, None, :]).reshape(T, PEER_HEADS, PEER_TOPK * PEER_TOPK)
    cidx = (si[:, :, 0, :, None] * PEER_N_KEYS + si[:, :, 1, None, :]).reshape(T, PEER_HEADS, PEER_TOPK * PEER_TOPK)
    top_s, top_pos = lax.top_k(cand, PEER_TOPK)
    eidx = jnp.take_along_axis(cidx, top_pos, axis=-1)
    g = jax.nn.softmax(top_s, axis=-1).astype(x.dtype)
    nc = T // PEER_TOKEN_BLOCK

    def block(args):
        tb, ib, gb = args
        act = jax.nn.gelu(jnp.einsum('thkd,td->thk', expert_u[ib], tb), approximate=False)
        return jnp.einsum('thk,thkd->td', gb * act, expert_v[ib])

    y = lax.map(block, (t.reshape(nc, PEER_TOKEN_BLOCK, D),
                        eidx.reshape(nc, PEER_TOKEN_BLOCK, PEER_HEADS, PEER_TOPK),
                        g.reshape(nc, PEER_TOKEN_BLOCK, PEER_HEADS, PEER_TOPK)))
    return y.reshape(B_, S_, D)


def setup_inputs(seed: int = 0) -> dict:
    key = jax.random.key(seed)
    ks = iter(jax.random.split(key, 32))

    def nrm(shape, scale):
        return jax.random.normal(next(ks), shape, jnp.float32) * scale

    def gain(shape):
        return 1.0 + nrm(shape, 0.02)

    L = DEPTH
    return {
        'x': nrm((BATCH, SEQ, D_MODEL), 1.0),
        'mem': nrm((BATCH, N_MEM, D_MODEL), 1.0),
        'w_in': nrm((L, D_MODEL, IN_WIDTH), D_MODEL ** -0.5),
        'pool_w': nrm((L, POOL_GROUPS, POOL_GROUP_DIM, POOL_GROUP_DIM), POOL_GROUP_DIM ** -0.5),
        'pool_scale': gain((L, POOL_WIDTH)),
        'w_br_pool': nrm((L, POOL_WIDTH, D_MODEL), POOL_WIDTH ** -0.5),
        'lambda_q1': nrm((L, DA_QK_DIM), 0.1),
        'lambda_k1': nrm((L, DA_QK_DIM), 0.1),
        'lambda_q2': nrm((L, DA_QK_DIM), 0.1),
        'lambda_k2': nrm((L, DA_QK_DIM), 0.1),
        'subln_w': gain((L, DA_V_DIM)),
        'w_br_attn': nrm((L, DA_WIDTH, D_MODEL), DA_WIDTH ** -0.5),
        'w_out': nrm((L, D_MODEL, D_MODEL), DN_BETA * D_MODEL ** -0.5),
        'ln1_g': gain((L, D_MODEL)),
        'ln1_b': nrm((L, D_MODEL), 0.02),
        'w_cq': nrm((L, D_MODEL, D_MODEL), D_MODEL ** -0.5),
        'w_ckv': nrm((L, D_MODEL, 2 * D_MODEL), D_MODEL ** -0.5),
        'w_co': nrm((L, D_MODEL, D_MODEL), DN_BETA * D_MODEL ** -0.5),
        'ln2_g': gain((L, D_MODEL)),
        'ln2_b': nrm((L, D_MODEL), 0.02),
        'w_pq': nrm((L, D_MODEL, PEER_HEADS * PEER_QUERY_DIM), D_MODEL ** -0.5),
        'sub_keys': nrm((L, PEER_HEADS, 2, PEER_N_KEYS, PEER_HALF), PEER_HALF ** -0.5),
        'expert_u': nrm((L, PEER_N_EXPERTS, D_MODEL), D_MODEL ** -0.5),
        'expert_v': nrm((L, PEER_N_EXPERTS, D_MODEL), DN_BETA * PEER_HEADS ** -0.5),
        'ln3_g': gain((L, D_MODEL)),
        'ln3_b': nrm((L, D_MODEL), 0.02),
    }


def reference(x, mem, w_in, pool_w, pool_scale, w_br_pool, lambda_q1, lambda_k1, lambda_q2, lambda_k2,
              subln_w, w_br_attn, w_out, ln1_g, ln1_b, w_cq, w_ckv, w_co, ln2_g, ln2_b,
              w_pq, sub_keys, expert_u, expert_v, ln3_g, ln3_b):
    B_, S_, _ = x.shape
    for l in range(DEPTH):
        lam_init = 0.8 - 0.6 * math.exp(-0.3 * l)
        h = x @ w_in[l]
        p, q, k, v, gate_p, gate_a = jnp.split(h, IN_SPLITS, axis=-1)
        pooled = causal_multiscale_pool(p)
        y_pool = jnp.einsum('bsgc,gcd->bsgd', pooled, pool_w[l]).reshape(B_, S_, POOL_WIDTH) * pool_scale[l]
        y_pool = y_pool @ w_br_pool[l]
        lam = (jnp.exp(jnp.sum(lambda_q1[l].astype(jnp.float32) * lambda_k1[l].astype(jnp.float32)))
               - jnp.exp(jnp.sum(lambda_q2[l].astype(jnp.float32) * lambda_k2[l].astype(jnp.float32)))
               + lam_init)
        y_attn = diff_attention(q, k, v, lam, lam_init, subln_w[l]) @ w_br_attn[l]
        merged = jax.nn.sigmoid(gate_p) * y_pool + jax.nn.sigmoid(gate_a) * y_attn
        x = layer_norm(DN_ALPHA * x + merged @ w_out[l], ln1_g[l], ln1_b[l])
        x = layer_norm(DN_ALPHA * x + memory_cross_attention(x, mem, w_cq[l], w_ckv[l], w_co[l]), ln2_g[l], ln2_b[l])
        x = layer_norm(DN_ALPHA * x + peer(x, w_pq[l], sub_keys[l], expert_u[l], expert_v[l]), ln3_g[l], ln3_b[l])
    return x
```

```cpp
#include <hip/hip_runtime.h>
#include <hip/hip_cooperative_groups.h>
#include <stdint.h>
#include <cstdio>
namespace cg = cooperative_groups;

#ifndef PROBE_DUP
#define PROBE_DUP -1
#endif
#ifndef MK_MULTI
#define MK_MULTI 0
#endif

#define DI __device__ __forceinline__
typedef unsigned short bf16_t;
typedef short bf16x8 __attribute__((ext_vector_type(8)));
typedef short s16x4 __attribute__((ext_vector_type(4)));
typedef float f32x16 __attribute__((ext_vector_type(16)));
typedef float f32x4 __attribute__((ext_vector_type(4)));
typedef unsigned u32x4 __attribute__((ext_vector_type(4)));
typedef unsigned u32x2 __attribute__((ext_vector_type(2)));
typedef __bf16 bf16x2 __attribute__((ext_vector_type(2)));
typedef float f32x2 __attribute__((ext_vector_type(2)));
#define MFMA32(a, b, c) __builtin_amdgcn_mfma_f32_32x32x16_bf16((a), (b), (c), 0, 0, 0)

constexpr int T = 16384, S = 8192, D = 1024;
constexpr int NTHR = 512;
constexpr int LDS_BYTES = 144 * 1024;
constexpr int NPHASE = 18;
constexpr float LOG2E = 1.4426950408889634f;
constexpr float DN_ALPHA = 1.189207115002721f;
constexpr float LN_EPS = 1e-5f;

constexpr size_t MB = 1024 * 1024;
constexpr size_t WS_CTL   = 0;
constexpr size_t WS_SU    = 65536;
constexpr size_t WS_SV    = 131072;
constexpr size_t WS_EU    = 1 * MB;
constexpr size_t WS_EV    = WS_EU + 32 * MB;
constexpr size_t WS_XB    = WS_EV + 32 * MB;
constexpr size_t WS_WINT  = WS_XB + 32 * MB;
constexpr size_t WS_WCT   = WS_WINT + 11 * MB;
constexpr size_t WS_WBAT  = WS_WCT + 1 * MB;
constexpr size_t WS_WOUTT = WS_WBAT + 2 * MB;
constexpr size_t WS_WCQT  = WS_WOUTT + 2 * MB;
constexpr size_t WS_WCKVT = WS_WCQT + 2 * MB;
constexpr size_t WS_WCOT  = WS_WCKVT + 4 * MB;
constexpr size_t WS_WPQT  = WS_WCOT + 2 * MB;
constexpr size_t WS_MEMB  = WS_WPQT + 2 * MB;
constexpr size_t WS_KC    = WS_MEMB + 1 * MB;
constexpr size_t WS_VCT   = WS_KC + 1 * MB;
constexpr size_t WS_KEYH  = WS_VCT + 1 * MB;
constexpr size_t WS_KEYL  = WS_KEYH + 256 * 1024;
constexpr size_t WS_PB    = WS_KEYL + 256 * 1024 + 512 * 1024;
constexpr size_t WS_POOL  = WS_PB + 16 * MB;
constexpr size_t WS_QB    = WS_POOL + 16 * MB;
constexpr size_t WS_KB    = WS_QB + 32 * MB;
constexpr size_t WS_VT    = WS_KB + 32 * MB;
constexpr size_t WS_END   = WS_VT + 32 * MB;
constexpr size_t WS_EIDX  = WS_WINT;
constexpr size_t WS_GW    = WS_WINT + 8 * MB;
static_assert(WS_END <= 256 * MB, "workspace overflow");
static_assert(WS_GW + 8 * MB <= WS_WPQT, "eidx/gw overlay");

struct Params {
    const float* in[26];
    float* out; unsigned char* ws;
    int ph_lo, ph_hi, use_cg, pad;
};
enum { I_X = 0, I_MEM, I_WIN, I_POOLW, I_POOLS, I_WBP, I_LQ1, I_LK1, I_LQ2, I_LK2, I_SUBLN, I_WBA, I_WOUT, I_LN1G, I_LN1B, I_WCQ, I_WCKV, I_WCO, I_LN2G, I_LN2B, I_WPQ, I_KEYS, I_EU, I_EV, I_LN3G, I_LN3B };

DI unsigned pk_bf16(float lo, float hi) { const f32x2 v = {lo, hi}; const bf16x2 b = __builtin_convertvector(v, bf16x2); return __builtin_bit_cast(unsigned, b); }
DI bf16_t f2bf(float x) { return (bf16_t)(pk_bf16(x, 0.f) & 0xffffu); }
DI float bf2f(unsigned short v) { return __uint_as_float(((unsigned)v) << 16); }
DI float bflo(unsigned v) { return __uint_as_float(v << 16); }
DI float bfhi(unsigned v) { return __uint_as_float(v & 0xffff0000u); }
DI int crow(int i, int hh) { return (i & 3) + 8 * (i >> 2) + 4 * hh; }
DI float fexp2(float x) { return __builtin_amdgcn_exp2f(x); }
DI float dot2(unsigned a, unsigned b, float acc) { return __builtin_amdgcn_fdot2_f32_bf16(__builtin_bit_cast(bf16x2, a), __builtin_bit_cast(bf16x2, b), acc, false); }
DI int swz(int r, int c) { return r * 128 + ((c ^ ((r >> 1) & 7)) << 4); }
DI int swp(int r, int c) { return r * 144 + (c << 4); }

#define XB_TMO      128
#define XB_XCNT(j)  (256  + 64 * (j))
#define XB_XSUB(j)  (1280 + 64 * (j))
#define XB_XGEN(j)  (2304 + 64 * (j))
#define XB_TOP      3328
#define XB_TOPGEN   3392
#define XCD_BAR_WORDS 3456
#define XB_SPIN_CAP (1u << 18)
#define LAS __attribute__((address_space(3)))

__device__ __forceinline__ unsigned xb_ld(unsigned* p)              { return __hip_atomic_load(p, __ATOMIC_RELAXED, __HIP_MEMORY_SCOPE_AGENT); }
__device__ __forceinline__ unsigned xb_add(unsigned* p, unsigned v) { return __hip_atomic_fetch_add(p, v, __ATOMIC_RELAXED, __HIP_MEMORY_SCOPE_AGENT); }
__device__ __forceinline__ unsigned xb_xcc_id() { return (unsigned)__builtin_amdgcn_s_getreg((3 << 11) | 20) & 0xFu; }
#define XB_SPIN(cond, bar) do { unsigned _sp = 0; while (cond) { __builtin_amdgcn_s_sleep(1); \
    if ((++_sp & 255u) == 0u) { if (xb_ld(&(bar)[XB_TMO])) break; if (_sp > XB_SPIN_CAP) { atomicAdd(&(bar)[XB_TMO], 1u); break; } } } } while (0)

struct XcdBarrier {
    unsigned* bar; unsigned x;
    volatile LAS unsigned* st;
};

__device__ __forceinline__ XcdBarrier xcd_barrier_post(unsigned* bar, volatile LAS unsigned* st) {
    XcdBarrier b; b.bar = bar; b.x = xb_xcc_id(); b.st = st;
    if (threadIdx.x == 0) (void)xb_add(&bar[XB_XCNT(b.x)], 1u);
    return b;
}
__device__ __forceinline__ void xcd_barrier_complete(unsigned* bar, unsigned x, unsigned& nloc, unsigned& nx) {
    const unsigned G = gridDim.x * gridDim.y * gridDim.z;
    unsigned sum, cnt, mine, sp = 0u;
    for (;;) {
        sum = 0u; cnt = 0u; mine = 0u;
#pragma unroll
        for (unsigned j = 0; j < 16; ++j) { const unsigned c = xb_ld(&bar[XB_XCNT(j)]); sum += c; cnt += (c > 0u) ? 1u : 0u; mine = (j == x) ? c : mine; }
        if (sum == G) break;
        __builtin_amdgcn_s_sleep(1);
        if ((++sp & 255u) == 0u) { if (xb_ld(&bar[XB_TMO])) break; if (sp > XB_SPIN_CAP) { atomicAdd(&bar[XB_TMO], 1u); break; } }
    }
    nloc = mine > 0u ? mine : 1u; nx = cnt > 0u ? cnt : 1u;
}

__device__ __forceinline__ void xcd_barrier(const XcdBarrier& b) {
    asm volatile("s_waitcnt vmcnt(0)" ::: "memory");
    __syncthreads();
    if (threadIdx.x == 0) {
        unsigned* bar = b.bar;
        __builtin_amdgcn_s_waitcnt(0);
        unsigned nloc = b.st[0], nx = b.st[1];
        if (nloc == 0u) { xcd_barrier_complete(bar, b.x, nloc, nx); b.st[0] = nloc; b.st[1] = nx; }
        const unsigned old = xb_add(&bar[XB_XSUB(b.x)], 1u);
        const unsigned gen = old / nloc;
        if (old + 1u == (gen + 1u) * nloc) {
            __builtin_amdgcn_fence(__ATOMIC_RELEASE, "agent");
            asm volatile("s_waitcnt vmcnt(0)" ::: "memory");
            const unsigned og = xb_add(&bar[XB_TOP], 1u);
            const unsigned tg = og / nx;
            if (og + 1u == (tg + 1u) * nx) xb_add(&bar[XB_TOPGEN], 1u);
            else XB_SPIN(xb_ld(&bar[XB_TOPGEN]) == tg, bar);
            __builtin_amdgcn_fence(__ATOMIC_ACQUIRE, "agent");
            xb_add(&bar[XB_XGEN(b.x)], 1u);
            asm volatile("s_waitcnt vmcnt(0)" ::: "memory");
        } else {
            XB_SPIN(xb_ld(&bar[XB_XGEN(b.x)]) == gen, bar);
            __builtin_amdgcn_fence(__ATOMIC_ACQUIRE, "agent");
            asm volatile("s_waitcnt vmcnt(0)" ::: "memory");
        }
    }
    __syncthreads();
}


namespace pg8 {
#define PG8_LAS __attribute__((address_space(3)))
typedef unsigned short bf16_t;
typedef short bf16x8 __attribute__((ext_vector_type(8)));
typedef float f32x4 __attribute__((ext_vector_type(4)));
typedef unsigned u32x4 __attribute__((ext_vector_type(4)));
constexpr int BM = 256, BK = 64, HALF = 128, HTB = HALF * BK * 2  , STAGE_BYTES = 8 * HTB, NXCD = 8, WGM = 8;

__host__ __device__ __forceinline__ int lds_byte(int r, int c) { const int st = (r >> 4) * 2 + (c >> 5), rr = r & 15, cc = c & 31, ob = rr * 64 + cc * 2; return st * 1024 + (ob ^ (((ob >> 9) & 1) << 5)); }
__host__ __device__ __forceinline__ void stage_rc(int b, int& R, int& C) { const int st = b / 1024, sb = b % 1024, swz = sb ^ (((sb >> 9) & 1) << 5); R = (st >> 1) * 16 + swz / 64; C = (st & 1) * 32 + (swz % 64) / 2; }
__host__ __device__ __forceinline__ int perm32(int rho) { const int n = rho >> 4, i = rho & 15; return 8 * (i >> 2) + 4 * n + (i & 3); }

struct Unit { int pm, pn; };
struct Gemm { const bf16_t* A; const bf16_t* Bt; int M, N, K; };

struct StaticOrder {
    int nM, nN, nwg, G, c;
    __host__ __device__ void init(int M, int N, int G_, int c_) { nM = M / BM; nN = N / BM; nwg = nM * nN; G = G_; c = c_; }
    __host__ __device__ bool next(int i, Unit& u) const {
        const long L = (long)i * G + c; if (L >= nwg) return false;
        int wgid = (int)L; { const int q = nwg / NXCD, r = nwg % NXCD, xcd = wgid % NXCD, off = wgid / NXCD; wgid = (xcd < r ? xcd * (q + 1) : r * (q + 1) + (xcd - r) * q) + off; }
        const int nig = WGM * nN, gid = wgid / nig, fm = gid * WGM, gsz = (nM - fm) < WGM ? (nM - fm) : WGM;
        u.pm = fm + ((wgid % nig) % gsz); u.pn = (wgid % nig) / gsz; return true;
    }
    __device__ __forceinline__ void a_ready(const Unit&) const {}
    __device__ __forceinline__ void done(const Unit&) const {}
};
template <class Epi, class Sched, bool ALIGN_EPI = false, bool SP2 = false>
__device__ __forceinline__ void gemm_phase(PG8_LAS unsigned char* lds, const Gemm g, const Sched& S, const Epi& E) {
    const int tid = threadIdx.x, wid = __builtin_amdgcn_readfirstlane(tid >> 6), lane = tid & 63, wr = wid >> 2, wc = wid & 3, fr = lane & 15, fq = lane >> 4;
    const int K = g.K, nt = K / BK;
    unsigned voffA[2], voffB[2];
#pragma unroll
    for (int i = 0; i < 2; ++i) { int R, C; stage_rc(tid * 16 + i * 8192, R, C); const int Rb = Epi::PERM ? ((R & ~31) + perm32(R & 31)) : R;
        voffA[i] = (unsigned)(R * K + C) * 2u; voffB[i] = (unsigned)(Rb * K + C) * 2u; }
    const size_t kstep = (size_t)(BK * 2);
    const size_t hstep = (size_t)HALF * K * 2;
    const size_t tstep = 2 * hstep;
    const unsigned ldsw = (unsigned)wid * 1024u;
    const int aoff = lds_byte(wr * 64 + fr, fq * 8), boff = lds_byte(wc * 32 + fr, fq * 8);
#define PG8_SA(b, h) (((b) * 2 + (h)) * HTB)
#define PG8_SB(b, h) ((4 + (b) * 2 + (h)) * HTB)
#define PG8_STAGE(bufoff, gbase, voff) do { _Pragma("unroll") for (int _i = 0; _i < 2; ++_i) \
        __builtin_amdgcn_global_load_lds((const unsigned*)((const char*)(gbase) + (voff)[_i]), (PG8_LAS unsigned*)(lds + (bufoff) + ldsw + _i * 8192), 16, 0, 0); } while (0)
#define PG8_LDA(dst, b, h) do { _Pragma("unroll") for (int m = 0; m < 4; ++m) _Pragma("unroll") for (int k = 0; k < 2; ++k) dst[m][k] = *(const PG8_LAS bf16x8*)(lds + PG8_SA(b, h) + aoff + m * 2048 + k * 1024); } while (0)
#define PG8_LDB(dst, b, h) do { _Pragma("unroll") for (int n = 0; n < 2; ++n) _Pragma("unroll") for (int k = 0; k < 2; ++k) dst[n][k] = *(const PG8_LAS bf16x8*)(lds + PG8_SB(b, h) + boff + n * 2048 + k * 1024); } while (0)
#define PG8_MMA(ai, bj, At, Bt) do { __builtin_amdgcn_s_setprio(1); _Pragma("unroll") for (int m = 0; m < 4; ++m) _Pragma("unroll") for (int n = 0; n < 2; ++n) _Pragma("unroll") for (int k = 0; k < 2; ++k) \
        acc[ai][bj][m][n] = __builtin_amdgcn_mfma_f32_16x16x32_bf16(Bt[n][k], At[m][k], acc[ai][bj][m][n], 0, 0, 0); __builtin_amdgcn_s_setprio(0); } while (0)
#define PG8_WAIT_V(n) asm volatile("s_waitcnt vmcnt(" #n ")" ::: "memory")
#define PG8_WAIT_L(n) asm volatile("s_waitcnt lgkmcnt(" #n ")" ::: "memory")
#define PG8_BAR __builtin_amdgcn_s_barrier()
#define PG8_SCHED __builtin_amdgcn_sched_barrier(0)
    Unit cur, nxt; int ui = 0;
    if (!S.next(0, cur)) return;
    f32x4 acc[2][2][4][2];
#pragma unroll
    for (int a = 0; a < 2; ++a)
#pragma unroll
        for (int b = 0; b < 2; ++b)
#pragma unroll
            for (int m = 0; m < 4; ++m)
#pragma unroll
                for (int n = 0; n < 2; ++n) acc[a][b][m][n] = (f32x4){0.f, 0.f, 0.f, 0.f};
    bf16x8 At[4][2], B0[2][2], B1[2][2];
    const char* cA = (const char*)g.A + (size_t)cur.pm * tstep; const char* cB = (const char*)g.Bt + (size_t)cur.pn * tstep;
    S.a_ready(cur);
    if constexpr (SP2) {
        PG8_STAGE(PG8_SB(0, 0), cB, voffB); PG8_STAGE(PG8_SB(0, 1), cB + hstep, voffB); PG8_STAGE(PG8_SA(0, 0), cA, voffA); PG8_STAGE(PG8_SA(0, 1), cA + hstep, voffA);
        if (wr == 1) PG8_BAR;
        PG8_WAIT_V(2); PG8_BAR;
        PG8_STAGE(PG8_SB(1, 0), cB + kstep, voffB); PG8_STAGE(PG8_SA(1, 0), cA + kstep, voffA); PG8_STAGE(PG8_SB(1, 1), cB + hstep + kstep, voffB);
        PG8_WAIT_V(6); PG8_BAR;
    } else {
        PG8_STAGE(PG8_SB(0, 0), cB, voffB); PG8_STAGE(PG8_SA(0, 0), cA, voffA); PG8_STAGE(PG8_SB(0, 1), cB + hstep, voffB); PG8_STAGE(PG8_SA(0, 1), cA + hstep, voffA);
        if (wr == 1) PG8_BAR;
        PG8_WAIT_V(4); PG8_BAR;
        PG8_STAGE(PG8_SB(1, 0), cB + kstep, voffB); PG8_STAGE(PG8_SA(1, 0), cA + kstep, voffA); PG8_STAGE(PG8_SB(1, 1), cB + hstep + kstep, voffB);
        PG8_WAIT_V(6); PG8_BAR;
    }
    for (;;) {
        const bool has_next = S.next(ui + 1, nxt);
        const char* nA = has_next ? (const char*)g.A + (size_t)nxt.pm * tstep : cA; const char* nB = has_next ? (const char*)g.Bt + (size_t)nxt.pn * tstep : cB;
        for (int t = 0; t < nt; t += 2) {
            const bool last = (t == nt - 2);
            const char* a1 = cA + (size_t)(t + 1) * kstep;
            const char* a2 = last ? nA : cA + (size_t)(t + 2) * kstep; const char* b2 = last ? nB : cB + (size_t)(t + 2) * kstep;
            const char* a3 = a2 + kstep; const char* b3 = b2 + kstep;
            if (last && has_next) S.a_ready(nxt);
            if constexpr (SP2) {
            PG8_LDB(B0, 0, 0); PG8_LDB(B1, 0, 1); PG8_SCHED; PG8_LDA(At, 0, 0); PG8_STAGE(PG8_SA(1, 1), a1 + hstep, voffA);
            PG8_WAIT_V(8); PG8_WAIT_L(0); PG8_BAR; PG8_MMA(0, 0, At, B0); PG8_MMA(0, 1, At, B1); PG8_BAR; PG8_SCHED;
            PG8_LDA(At, 0, 1); PG8_STAGE(PG8_SB(0, 0), b2, voffB); PG8_STAGE(PG8_SB(0, 1), b2 + hstep, voffB); PG8_STAGE(PG8_SA(0, 0), a2, voffA);
            PG8_WAIT_V(8); PG8_WAIT_L(0); PG8_BAR; PG8_MMA(1, 0, At, B0); PG8_MMA(1, 1, At, B1); PG8_BAR; PG8_SCHED;
            PG8_LDB(B0, 1, 0); PG8_LDB(B1, 1, 1); PG8_SCHED; PG8_LDA(At, 1, 0); PG8_STAGE(PG8_SA(0, 1), a2 + hstep, voffA);
            PG8_WAIT_V(8); PG8_WAIT_L(0); PG8_BAR; PG8_MMA(0, 0, At, B0); PG8_MMA(0, 1, At, B1); PG8_BAR; PG8_SCHED;
            PG8_LDA(At, 1, 1); PG8_STAGE(PG8_SB(1, 0), b3, voffB); PG8_STAGE(PG8_SB(1, 1), b3 + hstep, voffB); PG8_STAGE(PG8_SA(1, 0), a3, voffA);
            PG8_WAIT_V(8); PG8_WAIT_L(0); PG8_BAR; PG8_MMA(1, 0, At, B0); PG8_MMA(1, 1, At, B1); PG8_BAR; PG8_SCHED;
            } else {
            PG8_LDB(B0, 0, 0); PG8_SCHED; PG8_LDA(At, 0, 0); PG8_STAGE(PG8_SA(1, 1), a1 + hstep, voffA);
            PG8_WAIT_L(8); PG8_BAR; PG8_WAIT_L(0); PG8_MMA(0, 0, At, B0); PG8_BAR; PG8_SCHED;
            PG8_LDB(B1, 0, 1); PG8_STAGE(PG8_SB(0, 0), b2, voffB);
            PG8_BAR; PG8_WAIT_L(0); PG8_MMA(0, 1, At, B1); PG8_BAR;
            PG8_LDA(At, 0, 1); PG8_STAGE(PG8_SA(0, 0), a2, voffA);
            PG8_BAR; PG8_WAIT_L(0); PG8_MMA(1, 0, At, B0); PG8_BAR; PG8_SCHED;
            PG8_STAGE(PG8_SB(0, 1), b2 + hstep, voffB);
            PG8_WAIT_V(6); PG8_BAR; PG8_MMA(1, 1, At, B1); PG8_BAR;
            PG8_LDB(B0, 1, 0); PG8_SCHED; PG8_LDA(At, 1, 0); PG8_STAGE(PG8_SA(0, 1), a2 + hstep, voffA);
            PG8_WAIT_L(8); PG8_BAR; PG8_WAIT_L(0); PG8_MMA(0, 0, At, B0); PG8_BAR; PG8_SCHED;
            PG8_LDB(B1, 1, 1); PG8_STAGE(PG8_SB(1, 0), b3, voffB);
            PG8_BAR; PG8_WAIT_L(0); PG8_MMA(0, 1, At, B1); PG8_BAR;
            PG8_LDA(At, 1, 1); PG8_STAGE(PG8_SA(1, 0), a3, voffA);
            PG8_BAR; PG8_WAIT_L(0); PG8_MMA(1, 0, At, B0); PG8_BAR; PG8_SCHED;
            PG8_STAGE(PG8_SB(1, 1), b3 + hstep, voffB);
            PG8_WAIT_V(6); PG8_BAR; PG8_MMA(1, 1, At, B1); PG8_BAR;
            }
        }
        if constexpr (ALIGN_EPI) { if (wr == 0) PG8_BAR; }
        if constexpr (!Epi::AFTER_DRAIN) { E(acc, cur, wr, wc, fr, fq); S.done(cur); }
        if (!has_next) break;
#pragma unroll
        for (int a = 0; a < 2; ++a)
#pragma unroll
            for (int b = 0; b < 2; ++b)
#pragma unroll
                for (int m = 0; m < 4; ++m)
#pragma unroll
                    for (int n = 0; n < 2; ++n) acc[a][b][m][n] = (f32x4){0.f, 0.f, 0.f, 0.f};
        cur = nxt; cA = nA; cB = nB; ++ui;
        if constexpr (ALIGN_EPI) { if (wr == 1) PG8_BAR; }
    }
    PG8_WAIT_V(0);
    if constexpr (!ALIGN_EPI) { if (wr == 0) PG8_BAR; }
    PG8_BAR;
    if constexpr (Epi::AFTER_DRAIN) { E.fused(acc, cur, wr, wc, fr, fq, lds, wid, lane); S.done(cur); }
#undef PG8_SA
#undef PG8_SB
#undef PG8_STAGE
#undef PG8_LDA
#undef PG8_LDB
#undef PG8_MMA
#undef PG8_WAIT_V
#undef PG8_WAIT_L
#undef PG8_BAR
#undef PG8_SCHED
}
}

DI void cvt_rows(const float* __restrict__ src, bf16_t* __restrict__ dst, size_t n8) {
    for (size_t i = (size_t)blockIdx.x * NTHR + threadIdx.x; i < n8; i += (size_t)gridDim.x * NTHR) {
        const f32x4 a = *(const f32x4*)(src + i * 8), b = *(const f32x4*)(src + i * 8 + 4);
        u32x4 o; o.x = pk_bf16(a[0], a[1]); o.y = pk_bf16(a[2], a[3]); o.z = pk_bf16(b[0], b[1]); o.w = pk_bf16(b[2], b[3]);
        *(u32x4*)(dst + i * 8) = o;
    }
}
DI void cvt_rows_fp8(const float* __restrict__ src, unsigned char* __restrict__ dst, float* __restrict__ inv) {
    const int lane = threadIdx.x & 63, w = threadIdx.x >> 6;
    for (int r0 = (blockIdx.x * 8 + w) * 2; r0 < 16384; r0 += gridDim.x * 16) {
        f32x4 v[2][4]; float m[2] = {0.f, 0.f};
#pragma unroll
        for (int k = 0; k < 2; ++k)
#pragma unroll
            for (int i = 0; i < 4; ++i) v[k][i] = *(const f32x4*)(src + (size_t)(r0 + k) * 1024 + lane * 16 + i * 4);
#pragma unroll
        for (int k = 0; k < 2; ++k) {
#pragma unroll
            for (int i = 0; i < 4; ++i) m[k] = fmaxf(m[k], fmaxf(fmaxf(fabsf(v[k][i][0]), fabsf(v[k][i][1])), fmaxf(fabsf(v[k][i][2]), fabsf(v[k][i][3]))));
#pragma unroll
            for (int o = 32; o >= 1; o >>= 1) m[k] = fmaxf(m[k], __shfl_xor(m[k], o));
            const float sc = m[k] > 0.f ? 448.f / m[k] : 1.f;
            u32x4 q;
#pragma unroll
            for (int i = 0; i < 4; ++i) { int wd = 0; wd = __builtin_amdgcn_cvt_pk_fp8_f32(v[k][i][0] * sc, v[k][i][1] * sc, wd, false); wd = __builtin_amdgcn_cvt_pk_fp8_f32(v[k][i][2] * sc, v[k][i][3] * sc, wd, true); q[i] = (unsigned)wd; }
            *(u32x4*)(dst + (size_t)(r0 + k) * 1024 + lane * 16) = q;
            if (lane == 0) inv[r0 + k] = m[k] > 0.f ? m[k] / 448.f : 1.f;
        }
    }
}
DI void transpose_cvt(const float* __restrict__ src, int K, int N, bf16_t* __restrict__ dst, unsigned char* smem) {
    float* tl = (float*)smem;
    const int tk = K / 64, tn = N / 64, t = threadIdx.x;
    for (int tile = blockIdx.x; tile < tk * tn; tile += gridDim.x) {
        const int k0 = (tile / tn) * 64, n0 = (tile % tn) * 64;
#pragma unroll
        for (int i = 0; i < 8; ++i) { const int id = t + 512 * i, kk = id >> 6, nn = id & 63; tl[kk * 65 + nn] = src[(size_t)(k0 + kk) * N + n0 + nn]; }
        __syncthreads();
#pragma unroll
        for (int i = 0; i < 4; ++i) { const int id = t + 512 * i, nn = id >> 5, kp = id & 31;
            *(unsigned*)(dst + (size_t)(n0 + nn) * K + k0 + 2 * kp) = pk_bf16(tl[(2 * kp) * 65 + nn], tl[(2 * kp + 1) * 65 + nn]); }
        __syncthreads();
    }
}
DI void phase_prep(const Params& p, unsigned char* smem) {
    unsigned char* ws = p.ws;
    cvt_rows(p.in[I_X], (bf16_t*)(ws + WS_XB), (size_t)T * D / 8);
    cvt_rows(p.in[I_MEM], (bf16_t*)(ws + WS_MEMB), (size_t)512 * 1024 / 8);
    transpose_cvt(p.in[I_WIN], 1024, 5632, (bf16_t*)(ws + WS_WINT), smem);
    transpose_cvt(p.in[I_WBA], 1024, 1024, (bf16_t*)(ws + WS_WBAT), smem);
    transpose_cvt(p.in[I_WOUT], 1024, 1024, (bf16_t*)(ws + WS_WOUTT), smem);
    transpose_cvt(p.in[I_WCQ], 1024, 1024, (bf16_t*)(ws + WS_WCQT), smem);
    transpose_cvt(p.in[I_WCKV], 1024, 2048, (bf16_t*)(ws + WS_WCKVT), smem);
    transpose_cvt(p.in[I_WCO], 1024, 1024, (bf16_t*)(ws + WS_WCOT), smem);
    transpose_cvt(p.in[I_WPQ], 1024, 1024, (bf16_t*)(ws + WS_WPQT), smem);
    {
        const float* pw = p.in[I_POOLW]; const float* ps = p.in[I_POOLS]; const float* wb = p.in[I_WBP];
        bf16_t* wct = (bf16_t*)(ws + WS_WCT);
        float* coef = (float*)smem;
        for (int gc = blockIdx.x; gc < 512; gc += gridDim.x) {
            const int g = gc >> 7;
            __syncthreads();
            if (threadIdx.x < 128) coef[threadIdx.x] = pw[(size_t)gc * 128 + threadIdx.x] * ps[g * 128 + threadIdx.x];
            __syncthreads();
            const float* wp = wb + (size_t)(g * 128) * 1024 + threadIdx.x * 2;
            f32x2 acc = {0.f, 0.f};
#pragma unroll 16
            for (int d = 0; d < 128; ++d) { const f32x2 v = *(const f32x2*)(wp + (size_t)d * 1024); const float c = coef[d]; acc.x += c * v.x; acc.y += c * v.y; }
            wct[(size_t)(threadIdx.x * 2) * 512 + gc] = f2bf(acc.x); wct[(size_t)(threadIdx.x * 2 + 1) * 512 + gc] = f2bf(acc.y);
        }
        __syncthreads();
    }
    {
        const float* sk = p.in[I_KEYS]; bf16_t* kh = (bf16_t*)(ws + WS_KEYH); bf16_t* kl = (bf16_t*)(ws + WS_KEYL);
        for (int i = blockIdx.x * NTHR + threadIdx.x; i < 131072; i += gridDim.x * NTHR) {
            const float v = sk[i]; const bf16_t h = f2bf(v); kh[i] = h; kl[i] = f2bf(v - bf2f(h));
        }
    }
    if (blockIdx.x == 0 && threadIdx.x < 128) ((unsigned*)(ws + WS_CTL))[64 + threadIdx.x] = 0u;
}

#define EPI_FOREACH(...) _Pragma("unroll") for (int ai = 0; ai < 2; ++ai) _Pragma("unroll") for (int m = 0; m < 4; ++m) _Pragma("unroll") for (int bj = 0; bj < 2; ++bj) { \
        const int r = u.pm * 256 + ai * 128 + wr * 64 + m * 16 + fr, c = u.pn * 256 + bj * 128 + wc * 32 + 8 * fq; const f32x4 v0 = acc[ai][bj][m][0], v1 = acc[ai][bj][m][1]; __VA_ARGS__ }
DI u32x4 pk8(const f32x4 a, const f32x4 b) { u32x4 o; o.x = pk_bf16(a[0], a[1]); o.y = pk_bf16(a[2], a[3]); o.z = pk_bf16(b[0], b[1]); o.w = pk_bf16(b[2], b[3]); return o; }

struct EpiInproj {
    static constexpr bool PERM = true, AFTER_DRAIN = false;
    unsigned char* ws; bf16_t* gates;
    DI void operator()(const f32x4 (&acc)[2][2][4][2], const pg8::Unit& u, int wr, int wc, int fr, int fq) const {
        const int col0 = u.pn * 256;
        if (col0 < 512) { bf16_t* o = (bf16_t*)(ws + WS_PB); EPI_FOREACH({ *(u32x4*)(o + (size_t)r * 512 + c) = pk8(v0, v1); }) }
        else if (col0 < 2560) {
            const bool isq = col0 < 1536; const int cb = isq ? 512 : 1536; const float sc = isq ? 0.125f * LOG2E : 1.f;
            bf16_t* o = (bf16_t*)(ws + (isq ? WS_QB : WS_KB)) - cb;
            float mxs[2] = {0.f, 0.f};
            EPI_FOREACH({ const f32x4 a0 = v0 * sc; const f32x4 a1 = v1 * sc; *(u32x4*)(o + (size_t)r * 1024 + c) = pk8(a0, a1);
                float ss = (a0[0] * a0[0] + a0[1] * a0[1]) + (a0[2] * a0[2] + a0[3] * a0[3]) + (a1[0] * a1[0] + a1[1] * a1[1]) + (a1[2] * a1[2] + a1[3] * a1[3]);
                ss += __shfl_xor(ss, 16); ss += __shfl_xor(ss, 32);
                mxs[bj] = fmaxf(mxs[bj], ss); })
            unsigned* nm = (unsigned*)(ws + WS_CTL) + 128 + (isq ? 0 : 32);
#pragma unroll
            for (int bj = 0; bj < 2; ++bj) {
                float m = mxs[bj];
                m = fmaxf(m, __shfl_xor(m, 1)); m = fmaxf(m, __shfl_xor(m, 2)); m = fmaxf(m, __shfl_xor(m, 4)); m = fmaxf(m, __shfl_xor(m, 8));
                if ((threadIdx.x & 63) == 0) atomicMax(nm + ((col0 - cb + 128 * bj + 32 * wc) >> 5), __float_as_uint(m));
            }
        }
        else if (col0 < 3584) { bf16_t* o = (bf16_t*)(ws + WS_VT); EPI_FOREACH({ const int bb = r >> 13, ss = r & 8191, cc = c - 2560; _Pragma("unroll") for (int k = 0; k < 4; ++k) { o[((size_t)(bb * 1024 + cc + k)) * S + ss] = f2bf(v0[k]); o[((size_t)(bb * 1024 + cc + 4 + k)) * S + ss] = f2bf(v1[k]); } }) }
        else { bf16_t* o = gates + (col0 < 4608 ? (ptrdiff_t)-3584 : (ptrdiff_t)((size_t)T * 1024 - 4608));
            EPI_FOREACH({ f32x4 g0, g1;
                _Pragma("unroll") for (int k = 0; k < 4; ++k) { g0[k] = __builtin_amdgcn_rcpf(1.f + __expf(-v0[k])); g1[k] = __builtin_amdgcn_rcpf(1.f + __expf(-v1[k])); }
                *(u32x4*)(o + (size_t)r * 1024 + c) = pk8(g0, g1); }) }
    }
};
struct EpiKv {
    static constexpr bool PERM = true, AFTER_DRAIN = false;
    unsigned char* ws;
    DI void operator()(const f32x4 (&acc)[2][2][4][2], const pg8::Unit& u, int wr, int wc, int fr, int fq) const {
        if (u.pn < 4) { bf16_t* o = (bf16_t*)(ws + WS_KC); EPI_FOREACH({ *(u32x4*)(o + (size_t)r * 1024 + c) = pk8(v0, v1); }) }
        else { bf16_t* o = (bf16_t*)(ws + WS_VCT);
            EPI_FOREACH({ const int b = r >> 8, mm = r & 255, cc = c - 1024;
                _Pragma("unroll") for (int k = 0; k < 4; ++k) { o[((size_t)(b * 1024 + cc + k)) * 256 + mm] = f2bf(v0[k]); o[((size_t)(b * 1024 + cc + 4 + k)) * 256 + mm] = f2bf(v1[k]); } }) }
    }
};
template <int MODE> struct EpiN1024 {
    static constexpr bool PERM = true, AFTER_DRAIN = false;
    const float* resid; float* outf; bf16_t* outb; const bf16_t* gate; float scale;
    DI void operator()(const f32x4 (&acc)[2][2][4][2], const pg8::Unit& u, int wr, int wc, int fr, int fq) const {
        EPI_FOREACH({ const size_t o = (size_t)r * 1024 + c;
            if (MODE == 0) { const f32x4 x0 = *(const f32x4*)(resid + o), x1 = *(const f32x4*)(resid + o + 4); *(u32x4*)(outb + o) = pk8(x0 * DN_ALPHA + v0, x1 * DN_ALPHA + v1); }
            else if (MODE == 5) { const u32x4 g = *(const u32x4*)(gate + o); f32x4 x0, x1; x0[0] = bflo(g.x); x0[1] = bfhi(g.x); x0[2] = bflo(g.y); x0[3] = bfhi(g.y); x1[0] = bflo(g.z); x1[1] = bfhi(g.z); x1[2] = bflo(g.w); x1[3] = bfhi(g.w);
                *(u32x4*)(outb + o) = pk8(x0 * DN_ALPHA + v0, x1 * DN_ALPHA + v1); }
            else if (MODE == 1) *(u32x4*)(outb + o) = pk8(v0 * scale, v1 * scale);
            else if (MODE == 2) { *(f32x4*)(outf + o) = v0; *(f32x4*)(outf + o + 4) = v1; }
            else { const u32x4 g = *(const u32x4*)(gate + o); f32x4 y0, y1;
                y0[0] = v0[0] * bflo(g.x); y0[1] = v0[1] * bfhi(g.x); y0[2] = v0[2] * bflo(g.y); y0[3] = v0[3] * bfhi(g.y);
                y1[0] = v1[0] * bflo(g.z); y1[1] = v1[1] * bfhi(g.z); y1[2] = v1[2] * bflo(g.w); y1[3] = v1[3] * bfhi(g.w);
                if (MODE == 4) { const u32x4 mo = *(const u32x4*)(outb + o);
                    y0[0] += bflo(mo.x); y0[1] += bfhi(mo.x); y0[2] += bflo(mo.y); y0[3] += bfhi(mo.y); y1[0] += bflo(mo.z); y1[1] += bfhi(mo.z); y1[2] += bflo(mo.w); y1[3] += bfhi(mo.w); }
                *(u32x4*)(outb + o) = pk8(y0, y1); } })
    }
};
struct KvOrder {
    int c;
    DI bool next(int i, pg8::Unit& u) const { if (i != 0 || c < 128 || c >= 144) return false; const int j = c - 128; u.pm = j & 1; u.pn = j >> 1; return true; }
    DI void a_ready(const pg8::Unit&) const {}
    DI void done(const pg8::Unit&) const {}
};
#define LDS3(p) ((__attribute__((address_space(3))) unsigned char*)(p))

DI void phase_inproj(const Params& p, unsigned char* smem) {
    unsigned char* ws = p.ws;
    { pg8::Gemm g{(const bf16_t*)(ws + WS_XB), (const bf16_t*)(ws + WS_WINT), T, 5632, 1024}; pg8::StaticOrder so; so.init(T, 5632, (int)gridDim.x, (int)blockIdx.x);
      EpiInproj e{ws, (bf16_t*)(ws + WS_EU)};
      pg8::gemm_phase<EpiInproj, pg8::StaticOrder, true, true>(LDS3(smem), g, so, e); }
    __syncthreads();
    { pg8::Gemm g{(const bf16_t*)(ws + WS_MEMB), (const bf16_t*)(ws + WS_WCKVT), 512, 2048, 1024}; KvOrder ko{(int)blockIdx.x};
      EpiKv e{ws};
      pg8::gemm_phase<EpiKv, KvOrder, true, true>(LDS3(smem), g, ko, e); }
}

DI void pooled_pass(const Params& p) {
    const bf16_t* pb = (const bf16_t*)(p.ws + WS_PB); bf16_t* po = (bf16_t*)(p.ws + WS_POOL);
    for (int i = blockIdx.x * NTHR + threadIdx.x; i < T * 64; i += gridDim.x * NTHR) {
        const int tok = i >> 6, c8 = i & 63, s = tok & (S - 1), g = c8 >> 4, wnd = 2 << g;
        const int n = (s + 1 < wnd) ? s + 1 : wnd;
        float sum[8];
#pragma unroll
        for (int j = 0; j < 8; ++j) sum[j] = 0.f;
        u32x4 self;
        for (int k = 0; k < n; ++k) {
            const u32x4 v = *(const u32x4*)(pb + (size_t)(tok - k) * 512 + c8 * 8);
            if (k == 0) self = v;
            sum[0] += bflo(v.x); sum[1] += bfhi(v.x); sum[2] += bflo(v.y); sum[3] += bfhi(v.y); sum[4] += bflo(v.z); sum[5] += bfhi(v.z); sum[6] += bflo(v.w); sum[7] += bfhi(v.w);
        }
        const float inv = 1.f / (float)n;
        u32x4 o;
        o.x = pk_bf16(sum[0] * inv - bflo(self.x), sum[1] * inv - bfhi(self.x)); o.y = pk_bf16(sum[2] * inv - bflo(self.y), sum[3] * inv - bfhi(self.y));
        o.z = pk_bf16(sum[4] * inv - bflo(self.z), sum[5] * inv - bfhi(self.z)); o.w = pk_bf16(sum[6] * inv - bflo(self.w), sum[7] * inv - bfhi(self.w));
        *(u32x4*)(po + (size_t)tok * 512 + c8 * 8) = o;
    }
}

DI void attn_unit(const Params& p, int b, int h, int qb, int kt0, float mfix, float lam, unsigned char* smem) {
    const bf16_t* QB = (const bf16_t*)(p.ws + WS_QB); const bf16_t* KB = (const bf16_t*)(p.ws + WS_KB); const bf16_t* VT = (const bf16_t*)(p.ws + WS_VT);
    bf16_t* DA = (bf16_t*)p.out;
    const int t = threadIdx.x, lane = t & 63, w = t >> 6, map = w & 1, qg = w >> 1, hh = lane >> 5, ln = lane & 31;
    const int q0 = qb * 128, qpos = q0 + qg * 32 + ln;
    const float slope2 = exp2f(-(float)(h + 1)) * LOG2E;
    bf16x8 bq[4];
#pragma unroll
    for (int ks = 0; ks < 4; ++ks) bq[ks] = *(const bf16x8*)(QB + (size_t)(b * S + qpos) * 1024 + h * 128 + map * 64 + ks * 16 + hh * 8);
    f32x16 O[4];
#pragma unroll
    for (int k = 0; k < 4; ++k)
#pragma unroll
        for (int i = 0; i < 16; ++i) O[k][i] = 0.f;
    float l_run = 0.f;
    const int ntiles = 2 * qb + 2;
    u32x4 rk0[2], rv0[2], rk1[2], rv1[2];
#define A_LOAD(kt, rk, rv) { _Pragma("unroll") for (int i = 0; i < 2; ++i) { const int id = t + 512 * i, r = (id >> 3) & 63, c = id & 7; \
                         rk[i] = *(const u32x4*)(KB + (size_t)(b * S + (kt) * 64 + r) * 1024 + h * 128 + i * 64 + c * 8); } \
                     _Pragma("unroll") for (int i = 0; i < 2; ++i) { const int id = t + 512 * i, r = id >> 3, c = id & 7; \
                         rv[i] = *(const u32x4*)(VT + (size_t)((b * 8 + h) * 128 + r) * S + (kt) * 64 + c * 8); } }
#define A_STORE(buf, rk, rv) { unsigned char* sb_ = smem + (buf) * 36864; \
                     _Pragma("unroll") for (int i = 0; i < 2; ++i) { const int id = t + 512 * i, r = (id >> 3) & 63, c = id & 7; *(u32x4*)(sb_ + i * 9216 + swp(r, c)) = rk[i]; } \
                     _Pragma("unroll") for (int i = 0; i < 2; ++i) { const int id = t + 512 * i, r = id >> 3, c = id & 7; unsigned char* d_ = sb_ + 18432 + r * 144 + (c >> 1) * 32 + (c & 1) * 8; \
                         u32x2 lo_; lo_.x = rv[i].x; lo_.y = rv[i].y; u32x2 hi_; hi_.x = rv[i].z; hi_.y = rv[i].w; *(u32x2*)(d_) = lo_; *(u32x2*)(d_ + 16) = hi_; } }
    auto compute = [&](const int kt) __attribute__((always_inline)) {
        const int cur = kt & 1;
        const unsigned char* sK = smem + cur * 36864 + map * 9216;
        const unsigned char* sV = smem + cur * 36864 + 18432;
        const int koff = kt * 64 + 4 * hh;
        const float nmref = slope2 * (float)(koff - qpos) - mfix;
        f32x16 s[2];
#pragma unroll
        for (int sub = 0; sub < 2; ++sub)
#pragma unroll
            for (int i = 0; i < 16; ++i) s[sub][i] = fmaf(slope2, (float)(sub * 32 + (i & 3) + 8 * (i >> 2)), nmref);
        __builtin_amdgcn_s_setprio(1);
#pragma unroll
        for (int sub = 0; sub < 2; ++sub) {
#pragma unroll
            for (int ks = 0; ks < 4; ++ks) { const int r = sub * 32 + ln, c = 2 * ks + hh; const bf16x8 a = *(const bf16x8*)(sK + swp(r, c)); s[sub] = MFMA32(a, bq[ks], s[sub]); }
        }
        __builtin_amdgcn_s_setprio(0);
        float ps = 0.f;
        if (kt >= ntiles - 2) {
#pragma unroll
            for (int sub = 0; sub < 2; ++sub)
#pragma unroll
                for (int i = 0; i < 16; ++i) { const int c = sub * 32 + (i & 3) + 8 * (i >> 2); const float v = (c + koff > qpos) ? -1e30f : s[sub][i]; const float e = fexp2(v); s[sub][i] = e; ps += e; }
        } else {
#pragma unroll
            for (int sub = 0; sub < 2; ++sub)
#pragma unroll
                for (int i = 0; i < 16; ++i) { const float e = fexp2(s[sub][i]); s[sub][i] = e; ps += e; }
        }
        l_run += ps;
        bf16x8 pf[2][2];
#pragma unroll
        for (int sub = 0; sub < 2; ++sub)
#pragma unroll
            for (int st = 0; st < 2; ++st) {
                u32x4 q; q.x = pk_bf16(s[sub][8 * st], s[sub][8 * st + 1]); q.y = pk_bf16(s[sub][8 * st + 2], s[sub][8 * st + 3]);
                q.z = pk_bf16(s[sub][8 * st + 4], s[sub][8 * st + 5]); q.w = pk_bf16(s[sub][8 * st + 6], s[sub][8 * st + 7]);
                pf[sub][st] = __builtin_bit_cast(bf16x8, q);
            }
        __builtin_amdgcn_s_setprio(1);
#pragma unroll
        for (int blk = 0; blk < 4; ++blk)
#pragma unroll
            for (int sub = 0; sub < 2; ++sub)
#pragma unroll
                for (int st = 0; st < 2; ++st) {
                    const int r = blk * 32 + ln, ch = sub * 4 + 2 * st + hh;
                    const bf16x8 va = *(const bf16x8*)(sV + swp(r, ch));
                    O[blk] = MFMA32(va, pf[sub][st], O[blk]);
                }
        __builtin_amdgcn_s_setprio(0);
    };
    A_LOAD(kt0, rk0, rv0); A_STORE(kt0 & 1, rk0, rv0);
    if (kt0 + 1 < ntiles) A_LOAD(kt0 + 1, rk1, rv1);
    __syncthreads();
    for (int kt = kt0; kt < ntiles; kt += 2) {
        if (kt + 2 < ntiles) A_LOAD(kt + 2, rk0, rv0);
        compute(kt);
        if (kt + 1 < ntiles) A_STORE((kt + 1) & 1, rk1, rv1);
        __syncthreads();
        if (kt + 1 >= ntiles) break;
        if (kt + 3 < ntiles) A_LOAD(kt + 3, rk1, rv1);
        compute(kt + 1);
        if (kt + 2 < ntiles) A_STORE(kt & 1, rk0, rv0);
        __syncthreads();
    }
#undef A_LOAD
#undef A_STORE
    const float l_tot = l_run + __shfl_xor(l_run, 32), inv_l = 1.f / l_tot;
    float* ex = (float*)smem;
    if (map == 1) {
#pragma unroll
        for (int k = 0; k < 4; ++k)
#pragma unroll
            for (int i = 0; i < 16; ++i) ex[(qg * 64 + k * 16 + i) * 64 + lane] = O[k][i] * inv_l;
    }
    __syncthreads();
    if (map == 0) {
        float ssq = 0.f;
#pragma unroll
        for (int k = 0; k < 4; ++k)
#pragma unroll
            for (int i = 0; i < 16; ++i) { const float v = O[k][i] * inv_l - lam * ex[(qg * 64 + k * 16 + i) * 64 + lane]; O[k][i] = v; ssq += v * v; }
        ssq += __shfl_xor(ssq, 32);
        const float rs = rsqrtf(ssq * (1.f / 128.f) + LN_EPS) * 0.8f;
        const float* sw = p.in[I_SUBLN];
#pragma unroll
        for (int k = 0; k < 4; ++k)
#pragma unroll
            for (int g = 0; g < 4; ++g) {
                const int dv = k * 32 + 8 * g + 4 * hh;
                const f32x4 wv = *(const f32x4*)(sw + dv);
                u32x2 v; v.x = pk_bf16(O[k][4 * g] * rs * wv[0], O[k][4 * g + 1] * rs * wv[1]); v.y = pk_bf16(O[k][4 * g + 2] * rs * wv[2], O[k][4 * g + 3] * rs * wv[3]);
                *(u32x2*)(DA + (size_t)(b * S + qpos) * 1024 + h * 128 + dv) = v;
            }
    }
    __syncthreads();
}

DI void norm_pass(const Params& p) {
    unsigned* nm = (unsigned*)(p.ws + WS_CTL) + 128;
    const int t = threadIdx.x, chunk = t & 127, toff = t >> 7;
#pragma unroll
    for (int which = 0; which < 2; ++which) {
        const bf16_t* src = (const bf16_t*)(p.ws + (which ? WS_KB : WS_QB));
        float best = 0.f;
        for (int tok = blockIdx.x * 4 + toff; tok < T; tok += gridDim.x * 4) {
            const u32x4 v = *(const u32x4*)(src + (size_t)tok * 1024 + chunk * 8);
            float ss = bflo(v.x) * bflo(v.x) + bfhi(v.x) * bfhi(v.x) + bflo(v.y) * bflo(v.y) + bfhi(v.y) * bfhi(v.y)
                     + bflo(v.z) * bflo(v.z) + bfhi(v.z) * bfhi(v.z) + bflo(v.w) * bflo(v.w) + bfhi(v.w) * bfhi(v.w);
            ss += __shfl_xor(ss, 1); ss += __shfl_xor(ss, 2); ss += __shfl_xor(ss, 4);
            best = fmaxf(best, ss);
        }
        if ((t & 7) == 0) atomicMax(nm + which * 16 + (chunk >> 3), __float_as_uint(best));
    }
}
DI void phase_mix_a(const Params& p) { pooled_pass(p); }
DI void phase_mix(const Params& p, unsigned char* smem, int rep) {
    float lam;
    {
        float a = 0.f, c = 0.f;
        for (int i = 0; i < 64; ++i) { a += p.in[I_LQ1][i] * p.in[I_LK1][i]; c += p.in[I_LQ2][i] * p.in[I_LK2][i]; }
        lam = expf(a) - expf(c) + 0.2f;
    }
    const unsigned* nm = (const unsigned*)(p.ws + WS_CTL) + 128;
    unsigned* ctr = (unsigned*)(p.ws + WS_CTL) + 64 + rep;
    __shared__ int s_unit;
    for (;;) {
        if (threadIdx.x == 0) s_unit = (int)atomicAdd(ctr, 1u);
        __syncthreads();
        const int u = s_unit;
        __syncthreads();
        if (u >= 1024) break;
        const int qb = 63 - (u >> 4), bh = u & 15, h = bh & 7;
        const int g0 = 2 * (h * 2), g1 = 2 * (h * 2 + 1);
        const float bq0 = sqrtf((__uint_as_float(nm[g0]) + __uint_as_float(nm[g0 + 1])) * (__uint_as_float(nm[32 + g0]) + __uint_as_float(nm[32 + g0 + 1])));
        const float bq1 = sqrtf((__uint_as_float(nm[g1]) + __uint_as_float(nm[g1 + 1])) * (__uint_as_float(nm[32 + g1]) + __uint_as_float(nm[32 + g1 + 1])));
        const float bq = fmaxf(bq0, bq1) * 1.01f;
        const float slope2 = exp2f(-(float)(h + 1)) * LOG2E;
        const float dskip = (2.f * bq + 160.f) / slope2;
        int kt0 = 0;
        { const float lim = (float)(qb * 128 - 63) - dskip;
          if (lim > 0.f) kt0 = (int)ceilf(lim * (1.f / 64.f)); }
        if (kt0 > 2 * qb) kt0 = 2 * qb;
        attn_unit(p, bh >> 3, h, qb, kt0, bq, lam, smem);
    }
}

template <int MODE>
DI void phase_gemm1024(const bf16_t* A, const bf16_t* Bt, int K, const float* resid, float* outf, bf16_t* outb, const bf16_t* gate, float scale, unsigned char* smem) {
    pg8::Gemm g{A, Bt, T, 1024, K}; pg8::StaticOrder so; so.init(T, 1024, (int)gridDim.x, (int)blockIdx.x);
    EpiN1024<MODE> e{resid, outf, outb, gate, scale};
    pg8::gemm_phase<EpiN1024<MODE>, pg8::StaticOrder, true, true>(LDS3(smem), g, so, e);
}

DI void phase_ln(const bf16_t* xs, const float* g, const float* bta, bf16_t* outb) {
    const int lane = threadIdx.x & 63, w = threadIdx.x >> 6;
    for (int row = blockIdx.x * 8 + w; row < T; row += gridDim.x * 8) {
        const bf16_t* xr = xs + (size_t)row * 1024;
        f32x4 v[4]; float s = 0.f;
#pragma unroll
        for (int i = 0; i < 4; ++i) { const u32x2 xb = *(const u32x2*)(xr + i * 256 + lane * 4); v[i][0] = bflo(xb.x); v[i][1] = bfhi(xb.x); v[i][2] = bflo(xb.y); v[i][3] = bfhi(xb.y); s += (v[i][0] + v[i][1]) + (v[i][2] + v[i][3]); }
#pragma unroll
        for (int o = 32; o >= 1; o >>= 1) s += __shfl_xor(s, o);
        const float mu = s * (1.f / 1024.f); float q = 0.f;
#pragma unroll
        for (int i = 0; i < 4; ++i)
#pragma unroll
            for (int j = 0; j < 4; ++j) { const float d = v[i][j] - mu; q += d * d; }
#pragma unroll
        for (int o = 32; o >= 1; o >>= 1) q += __shfl_xor(q, o);
        const float rs = rsqrtf(q * (1.f / 1024.f) + LN_EPS);
#pragma unroll
        for (int i = 0; i < 4; ++i) {
            const int c = i * 256 + lane * 4;
            const f32x4 gg = *(const f32x4*)(g + c), bb = *(const f32x4*)(bta + c);
            f32x4 y;
#pragma unroll
            for (int j = 0; j < 4; ++j) y[j] = (v[i][j] - mu) * rs * gg[j] + bb[j];
            u32x2 ob; ob.x = pk_bf16(y[0], y[1]); ob.y = pk_bf16(y[2], y[3]);
            *(u32x2*)(outb + (size_t)row * 1024 + c) = ob;
        }
    }
}

DI int swz2(int r, int c) { return r * 528 + (c << 4); }
DI void phase_xattn(const Params& p, unsigned char* smem, int tile, int h) {
    const bf16_t* QC = (const bf16_t*)(p.ws + WS_QB); const bf16_t* KC = (const bf16_t*)(p.ws + WS_KC); const bf16_t* VCT = (const bf16_t*)(p.ws + WS_VCT);
    bf16_t* OC = (bf16_t*)(p.ws + WS_PB);
    const int t = threadIdx.x, lane = t & 63, w = t >> 6, hh = lane >> 5, ln = lane & 31;
    {
        const int tok0 = tile * 256, b = tok0 / S;
        const int tok = tok0 + w * 32 + ln;
        u32x4 rr[4];
#define X_LOAD(st) { _Pragma("unroll") for (int i = 0; i < 4; ++i) { const int id = t + 512 * i, r = id >> 5, c = id & 31; \
                         rr[i] = ((st) < 8) ? *(const u32x4*)(KC + (size_t)(b * 256 + ((st) & 3) * 64 + r) * 1024 + h * 256 + c * 8) \
                                            : *(const u32x4*)(VCT + (size_t)(b * 1024 + h * 256 + ((st) - 8) * 64 + r) * 256 + c * 8); } }
#define X_STORE(buf) { unsigned char* sb_ = smem + (buf) * 33792; _Pragma("unroll") for (int i = 0; i < 4; ++i) { const int id = t + 512 * i, r = id >> 5, c = id & 31; *(u32x4*)(sb_ + swz2(r, c)) = rr[i]; } }
        bf16x8 bqr[16];
#pragma unroll
        for (int ks = 0; ks < 16; ++ks) bqr[ks] = *(const bf16x8*)(QC + (size_t)tok * 1024 + h * 256 + ks * 16 + hh * 8);
        X_LOAD(0); X_STORE(0);
        __syncthreads();
        bf16x8 pf[8][2];
        float mx = -1e30f, psum = 0.f, inv_l = 0.f;
#pragma unroll
        for (int st = 0; st < 12; ++st) {
            const int cur = st & 1;
            if (st + 1 < 12) X_LOAD(st + 1);
            const unsigned char* sb = smem + cur * 33792;
            if (st < 8) {
#pragma unroll
                for (int sub = 0; sub < 2; ++sub) {
                    f32x16 a16;
#pragma unroll
                    for (int i = 0; i < 16; ++i) a16[i] = 0.f;
#pragma unroll
                    for (int ks = 0; ks < 16; ++ks) {
                        const bf16x8 bq = bqr[ks];
                        const int r = sub * 32 + ln, c = 2 * ks + hh;
                        const bf16x8 a = *(const bf16x8*)(sb + swz2(r, c));
                        a16 = MFMA32(a, bq, a16);
                    }
                    if (st < 4) {
#pragma unroll
                        for (int i = 0; i < 16; ++i) mx = fmaxf(mx, a16[i]);
                    } else {
#pragma unroll
                        for (int i = 0; i < 16; ++i) { a16[i] = fexp2(a16[i] - mx); psum += a16[i]; }
#pragma unroll
                        for (int s2 = 0; s2 < 2; ++s2) {
                            u32x4 q; q.x = pk_bf16(a16[8 * s2], a16[8 * s2 + 1]); q.y = pk_bf16(a16[8 * s2 + 2], a16[8 * s2 + 3]);
                            q.z = pk_bf16(a16[8 * s2 + 4], a16[8 * s2 + 5]); q.w = pk_bf16(a16[8 * s2 + 6], a16[8 * s2 + 7]);
                            pf[(st & 3) * 2 + sub][s2] = __builtin_bit_cast(bf16x8, q);
                        }
                    }
                }
                if (st == 3) mx = fmaxf(mx, __shfl_xor(mx, 32));
                if (st == 7) { psum += __shfl_xor(psum, 32); inv_l = 1.f / psum; }
            } else {
#pragma unroll
                for (int blk = 0; blk < 2; ++blk) {
                    f32x16 o16;
#pragma unroll
                    for (int i = 0; i < 16; ++i) o16[i] = 0.f;
#pragma unroll
                    for (int k = 0; k < 8; ++k)
#pragma unroll
                        for (int s2 = 0; s2 < 2; ++s2) {
                            const int r = blk * 32 + ln, ch = k * 4 + 2 * s2;
                            const s16x4 lo = *(const s16x4*)(sb + swz2(r, ch) + 8 * hh), hi = *(const s16x4*)(sb + swz2(r, ch + 1) + 8 * hh);
                            const bf16x8 va = __builtin_shufflevector(lo, hi, 0, 1, 2, 3, 4, 5, 6, 7);
                            o16 = MFMA32(va, pf[k][s2], o16);
                        }
#pragma unroll
                    for (int g = 0; g < 4; ++g) {
                        const int dv = (st - 8) * 64 + blk * 32 + 8 * g + 4 * hh;
                        u32x2 v; v.x = pk_bf16(o16[4 * g] * inv_l, o16[4 * g + 1] * inv_l); v.y = pk_bf16(o16[4 * g + 2] * inv_l, o16[4 * g + 3] * inv_l);
                        *(u32x2*)(OC + (size_t)tok * 1024 + h * 256 + dv) = v;
                    }
                }
            }
            if (st + 1 < 12) X_STORE(cur ^ 1);
            __syncthreads();
        }
#undef X_LOAD
#undef X_STORE
    }
}

DI int sortable(float v) { int b = __float_as_int(v); return b ^ ((b >> 31) & 0x7fffffff); }
#define CE_DESC(a, b) { const int hi_ = max(a, b), lo_ = min(a, b); a = hi_; b = lo_; }
template <int N> DI void bitonic_sort_desc(int (&k)[N]) {
#pragma unroll
    for (int sz = 2; sz <= N; sz <<= 1)
#pragma unroll
        for (int j = sz >> 1; j > 0; j >>= 1)
#pragma unroll
            for (int i = 0; i < N; ++i) {
                const int l = i ^ j;
                if (l > i) { if ((i & sz) == 0) { CE_DESC(k[i], k[l]); } else { CE_DESC(k[l], k[i]); } }
            }
}
DI void merge_top16(int (&a)[16], const int (&b)[16]) {
#pragma unroll
    for (int i = 0; i < 16; ++i) a[i] = max(a[i], b[15 - i]);
#pragma unroll
    for (int j = 8; j > 0; j >>= 1)
#pragma unroll
        for (int i = 0; i < 16; ++i) { const int l = i ^ j; if (l > i) CE_DESC(a[i], a[l]); }
}
__constant__ unsigned char PEER_CAND[64] = {
    0x00,0x01,0x02,0x03,0x04,0x05,0x06,0x07,0x08,0x09,0x0a,0x0b,0x0c,0x0d,0x0e,0x0f,
    0x10,0x11,0x12,0x13,0x14,0x15,0x16,0x17, 0x20,0x21,0x22,0x23,0x24, 0x30,0x31,0x32,0x33, 0x40,0x41,0x42, 0x50,0x51, 0x60,0x61, 0x70,0x71,
    0x80,0x90,0xa0,0xb0,0xc0,0xd0,0xe0,0xf0,
    0xff,0xff,0xff,0xff,0xff,0xff,0xff,0xff,0xff,0xff,0xff,0xff,0xff,0xff };
DI void phase_route(const Params& p, unsigned char* smem, int pm, int pn) {
    const float* PQ = (const float*)(p.ws + WS_PB);
    const bf16_t* KH = (const bf16_t*)(p.ws + WS_KEYH); const bf16_t* KL = (const bf16_t*)(p.ws + WS_KEYL);
    int* EIDX = (int*)(p.ws + WS_EIDX); float* GW = (float*)(p.ws + WS_GW);
    constexpr int SCP = 132;
    float* sc = (float*)smem;
    float* lval = (float*)(smem + 64 * 2 * SCP * 4);
    int* lidx = (int*)(lval + 64 * 2 * 16);
    const int t = threadIdx.x, lane = t & 63, w = t >> 6, hh = lane >> 5, ln = lane & 31;
    for (int uu = 0; uu < 8; ++uu) {
        const int tile = pm * 4 + (uu >> 1), h = pn * 2 + (uu & 1), t0 = tile * 64;
        {
            const int c = w & 1, ts = (w >> 1) & 1, kh2 = w >> 2;
            const int tok = t0 + ts * 32 + ln;
            bf16x8 qh[4], ql[4];
#pragma unroll
            for (int ks = 0; ks < 4; ++ks) {
                const float* qp = PQ + (size_t)tok * 1024 + h * 128 + c * 64 + ks * 16 + hh * 8;
                const f32x4 a = *(const f32x4*)qp, bb = *(const f32x4*)(qp + 4);
                u32x4 hv, lv;
                hv.x = pk_bf16(a[0], a[1]); hv.y = pk_bf16(a[2], a[3]); hv.z = pk_bf16(bb[0], bb[1]); hv.w = pk_bf16(bb[2], bb[3]);
                lv.x = pk_bf16(a[0] - bflo(hv.x), a[1] - bfhi(hv.x)); lv.y = pk_bf16(a[2] - bflo(hv.y), a[3] - bfhi(hv.y));
                lv.z = pk_bf16(bb[0] - bflo(hv.z), bb[1] - bfhi(hv.z)); lv.w = pk_bf16(bb[2] - bflo(hv.w), bb[3] - bfhi(hv.w));
                qh[ks] = __builtin_bit_cast(bf16x8, hv); ql[ks] = __builtin_bit_cast(bf16x8, lv);
            }
#pragma unroll
            for (int k2 = 0; k2 < 2; ++k2) {
                const int kb = kh2 * 2 + k2;
                f32x16 acc;
#pragma unroll
                for (int i = 0; i < 16; ++i) acc[i] = 0.f;
#pragma unroll
                for (int ks = 0; ks < 4; ++ks) {
                    const size_t off = ((size_t)((h * 2 + c) * 128 + kb * 32 + ln)) * 64 + ks * 16 + hh * 8;
                    const bf16x8 ah = *(const bf16x8*)(KH + off), al = *(const bf16x8*)(KL + off);
                    acc = MFMA32(ah, qh[ks], acc); acc = MFMA32(al, qh[ks], acc); acc = MFMA32(ah, ql[ks], acc);
                }
#pragma unroll
                for (int g = 0; g < 4; ++g) {
                    const int key = kb * 32 + 8 * g + 4 * hh, tokl = ts * 32 + ln;
                    f32x4 v; v[0] = acc[4 * g]; v[1] = acc[4 * g + 1]; v[2] = acc[4 * g + 2]; v[3] = acc[4 * g + 3];
                    *(f32x4*)(sc + (tokl * 2 + c) * SCP + key) = v;
                }
            }
        }
        __syncthreads();
        {
            const int tokl = t >> 3, c = (t >> 2) & 1, qtr = t & 3;
            const float* row = sc + (tokl * 2 + c) * SCP;
            int k32[32];
#pragma unroll
            for (int i4 = 0; i4 < 8; ++i4) {
                const f32x4 v = *(const f32x4*)(row + qtr * 32 + i4 * 4);
#pragma unroll
                for (int j = 0; j < 4; ++j) { const int idx = qtr * 32 + i4 * 4 + j; k32[i4 * 4 + j] = (sortable(v[j]) & ~127) | (127 - idx); }
            }
            bitonic_sort_desc<32>(k32);
            int k[16];
#pragma unroll
            for (int j = 0; j < 16; ++j) k[j] = k32[j];
#pragma unroll
            for (int rnd = 1; rnd <= 2; rnd <<= 1) {
                int o[16];
#pragma unroll
                for (int j = 0; j < 16; ++j) o[j] = __shfl_xor(k[j], rnd);
                merge_top16(k, o);
            }
#pragma unroll
            for (int q = 0; q < 4; ++q)
                if (qtr == q) {
#pragma unroll
                    for (int jj = 0; jj < 4; ++jj) { const int j = q * 4 + jj, idx = 127 - (k[j] & 127); lidx[(tokl * 2 + c) * 16 + j] = idx; lval[(tokl * 2 + c) * 16 + j] = row[idx]; }
                }
        }
        __syncthreads();
        if (t < 256) {
            const int tokl = t >> 2, part = t & 3;
            const float* l0 = lval + (tokl * 2) * 16; const float* l1 = l0 + 16;
            int k[16];
#pragma unroll
            for (int j = 0; j < 16; ++j) {
                const unsigned cj = PEER_CAND[part * 16 + j];
                const int i0 = (cj >> 4) & 15, j0 = cj & 15;
                const int key = (sortable(l0[i0] + l1[j0]) & ~255) | (255 - (i0 * 16 + j0));
                k[j] = cj == 0xffu ? (int)0x80000000 : key;
            }
            bitonic_sort_desc<16>(k);
#pragma unroll
            for (int rnd = 1; rnd <= 2; rnd <<= 1) {
                int o[16];
#pragma unroll
                for (int j = 0; j < 16; ++j) o[j] = __shfl_xor(k[j], rnd);
                merge_top16(k, o);
            }
            const int* i0p = lidx + (tokl * 2) * 16; const int* i1p = i0p + 16;
            float ts_[16]; int e_[16]; float mx = -1e30f;
#pragma unroll
            for (int j = 0; j < 16; ++j) {
                const int pos = 255 - (k[j] & 255), i0 = pos >> 4, j0 = pos & 15;
                ts_[j] = l0[i0] + l1[j0];
                e_[j] = i0p[i0] * 128 + i1p[j0];
                mx = fmaxf(mx, ts_[j]);
            }
            float sum = 0.f;
#pragma unroll
            for (int j = 0; j < 16; ++j) { ts_[j] = __expf(ts_[j] - mx); sum += ts_[j]; }
            const float inv = 1.f / sum;
            const size_t ob = (size_t)(t0 + tokl) * 128 + h * 16;
#pragma unroll
            for (int q = 0; q < 4; ++q)
                if (part == q) {
                    *(int4*)(EIDX + ob + q * 4) = make_int4(e_[q * 4], e_[q * 4 + 1], e_[q * 4 + 2], e_[q * 4 + 3]);
                    f32x4 g; g[0] = ts_[q * 4] * inv; g[1] = ts_[q * 4 + 1] * inv; g[2] = ts_[q * 4 + 2] * inv; g[3] = ts_[q * 4 + 3] * inv;
                    *(f32x4*)(GW + ob + q * 4) = g;
                }
        }
        __syncthreads();
    }
}

DI unsigned xcc_id() { return (unsigned)__builtin_amdgcn_s_getreg((3 << 11) | 20) & 7u; }
#define FP8_PAIRS(q, P) f32x2 P[8]; { _Pragma("unroll") for (int i_ = 0; i_ < 4; ++i_) { P[2 * i_] = __builtin_amdgcn_cvt_pk_f32_fp8((int)q[i_], false); P[2 * i_ + 1] = __builtin_amdgcn_cvt_pk_f32_fp8((int)q[i_], true); } }
constexpr int PEER_CHUNK = 256;

DI void phase_peer_u(const Params& p, unsigned char* smem, int rep) {
    const unsigned char* EU = p.ws + WS_EU; const bf16_t* X2B = (const bf16_t*)(p.ws + WS_XB);
    const int* EIDX = (const int*)(p.ws + WS_EIDX); bf16_t* PD = (bf16_t*)(p.ws + WS_PB);
    unsigned* q = (unsigned*)(p.ws + WS_CTL) + 72 + 16 * rep;
    const int lane = threadIdx.x & 63, w = threadIdx.x >> 6, sub = lane & 7, grp = lane >> 3;
    int* s_item = (int*)smem;
    const int x0 = (int)xcc_id();
    constexpr int NT = PEER_CHUNK / 8;
    for (int xs = 0; xs < 8; ++xs) {
        const int x = (x0 + xs) & 7;
        const unsigned char* EUx = EU + x * 128;
        const unsigned lane_off = (unsigned)sub * 16u;
        for (;;) {
            if (threadIdx.x == 0) s_item[0] = (int)atomicAdd(q + x, 1u);
            __syncthreads();
            const int item = s_item[0];
            __syncthreads();
            if (item >= T / PEER_CHUNK) break;
            const int tok0 = item * PEER_CHUNK + w;
#define U_IDX(n, lo, hi) { const int tk_ = tok0 + 8 * ((n) < NT ? (n) : NT - 1); lo = EIDX[(size_t)tk_ * 128 + lane]; hi = EIDX[(size_t)tk_ * 128 + 64 + lane]; }
#define U_TBL(n, lo, hi, tq, xv) { _Pragma("unroll") for (int i = 0; i < 16; ++i) { const int e = __shfl(i < 8 ? lo : hi, (i * 8 + grp) & 63); tq[i] = *(const u32x4*)(EUx + (((unsigned)e << 10) + lane_off)); } \
                const bf16_t* xp_ = X2B + (size_t)(tok0 + 8 * ((n) < NT ? (n) : NT - 1)) * 1024 + x * 128 + sub * 16; \
                _Pragma("unroll") for (int i = 0; i < 2; ++i) { const u32x4 v = *(const u32x4*)(xp_ + i * 8); xv[4 * i] = (f32x2){bflo(v.x), bfhi(v.x)}; xv[4 * i + 1] = (f32x2){bflo(v.y), bfhi(v.y)}; \
                    xv[4 * i + 2] = (f32x2){bflo(v.z), bfhi(v.z)}; xv[4 * i + 3] = (f32x2){bflo(v.w), bfhi(v.w)}; } }
            int eA_lo, eA_hi, eB_lo, eB_hi;
            u32x4 tqA[16], tqB[16]; f32x2 xvA[8], xvB[8];
            auto consume = [&](const u32x4 (&tq)[16], const f32x2 (&xv)[8], const int n) __attribute__((always_inline)) {
                float dv[16];
#pragma unroll
                for (int i = 0; i < 16; i += 2) {
                    FP8_PAIRS(tq[i], up);
                    FP8_PAIRS(tq[i + 1], uq);
                    f32x2 a0 = up[0] * xv[0], a1 = up[1] * xv[1], b0 = uq[0] * xv[0], b1 = uq[1] * xv[1];
#pragma unroll
                    for (int j = 2; j < 8; j += 2) { a0 = up[j] * xv[j] + a0; a1 = up[j + 1] * xv[j + 1] + a1; b0 = uq[j] * xv[j] + b0; b1 = uq[j + 1] * xv[j + 1] + b1; }
                    a0 += a1; b0 += b1;
                    dv[i] = a0.x + a0.y; dv[i + 1] = b0.x + b0.y;
                }
                float r_lo, r_hi;
                {
                    const bool c0 = sub & 1, c1 = (sub >> 1) & 1, c2 = sub >> 2;
                    float u4[8], u2[4];
#pragma unroll
                    for (int k = 0; k < 8; ++k) { const float keep = c0 ? dv[2 * k + 1] : dv[2 * k], give = c0 ? dv[2 * k] : dv[2 * k + 1]; u4[k] = keep + __shfl_xor(give, 1); }
#pragma unroll
                    for (int k = 0; k < 4; ++k) { const float keep = c1 ? u4[2 * k + 1] : u4[2 * k], give = c1 ? u4[2 * k] : u4[2 * k + 1]; u2[k] = keep + __shfl_xor(give, 2); }
                    { const float keep = c2 ? u2[1] : u2[0], give = c2 ? u2[0] : u2[1]; r_lo = keep + __shfl_xor(give, 4); }
                    { const float keep = c2 ? u2[3] : u2[2], give = c2 ? u2[2] : u2[3]; r_hi = keep + __shfl_xor(give, 4); }
                }
                bf16_t* po = PD + ((size_t)(tok0 + 8 * n) * 8 + x) * 128;
                po[sub * 8 + grp] = f2bf(r_lo); po[64 + sub * 8 + grp] = f2bf(r_hi);
            };
            U_IDX(0, eA_lo, eA_hi);
            U_IDX(1, eB_lo, eB_hi);
            U_TBL(0, eA_lo, eA_hi, tqA, xvA);
            for (int n = 0; n < NT; n += 2) {
                U_TBL(n + 1, eB_lo, eB_hi, tqB, xvB);
                U_IDX(n + 2, eA_lo, eA_hi);
                consume(tqA, xvA, n);
                U_TBL(n + 2, eA_lo, eA_hi, tqA, xvA);
                U_IDX(n + 3, eB_lo, eB_hi);
                consume(tqB, xvB, n + 1);
            }
#undef U_IDX
#undef U_TBL
        }
    }
}

DI void phase_peer_w(const Params& p) {
    const float* SU = (const float*)(p.ws + WS_SU); const float* SV = (const float*)(p.ws + WS_SV);
    const int* EIDX = (const int*)(p.ws + WS_EIDX); float* GW = (float*)(p.ws + WS_GW); const bf16_t* PD = (const bf16_t*)(p.ws + WS_PB);
    for (int i = blockIdx.x * NTHR + threadIdx.x; i < T * 128; i += gridDim.x * NTHR) {
        const int tok = i >> 7, k = i & 127, e = EIDX[i];
        float d = 0.f;
#pragma unroll
        for (int sl = 0; sl < 8; ++sl) d += bf2f(PD[((size_t)tok * 8 + sl) * 128 + k]);
        d *= SU[e];
        GW[i] = GW[i] * 0.5f * d * (1.f + erff(d * 0.70710678118654752f)) * SV[e];
    }
}

DI void phase_peer_v(const Params& p, unsigned char* smem, int rep) {
    const unsigned char* EV = p.ws + WS_EV;
    const int* EIDX = (const int*)(p.ws + WS_EIDX); const float* GW = (const float*)(p.ws + WS_GW);
    unsigned* q = (unsigned*)(p.ws + WS_CTL) + 80 + 16 * rep;
    const int lane = threadIdx.x & 63, w = threadIdx.x >> 6, sub = lane & 7, grp = lane >> 3;
    int* s_item = (int*)smem;
    const int x0 = (int)xcc_id();
    constexpr int NT = PEER_CHUNK / 8;
    const bool b0 = grp & 1, b1 = (grp >> 1) & 1, b2 = grp >> 2;
    for (int xs = 0; xs < 8; ++xs) {
        const int x = (x0 + xs) & 7;
        const unsigned char* EVx = EV + x * 128;
        const unsigned lane_off = (unsigned)sub * 16u;
        for (;;) {
            if (threadIdx.x == 0) s_item[0] = (int)atomicAdd(q + x, 1u);
            __syncthreads();
            const int item = s_item[0];
            __syncthreads();
            if (item >= T / PEER_CHUNK) break;
            const int tok0 = item * PEER_CHUNK + w;
#define V_IDX(n, lo, hi) { const int tk_ = tok0 + 8 * ((n) < NT ? (n) : NT - 1); lo = EIDX[(size_t)tk_ * 128 + lane]; hi = EIDX[(size_t)tk_ * 128 + 64 + lane]; }
#define V_TBL(n, lo, hi, tq, sc) { _Pragma("unroll") for (int i = 0; i < 16; ++i) { const int e = __shfl(i < 8 ? lo : hi, (i * 8 + grp) & 63); tq[i] = *(const u32x4*)(EVx + (((unsigned)e << 10) + lane_off)); } \
                const size_t tk_ = (size_t)(tok0 + 8 * ((n) < NT ? (n) : NT - 1)); sc[0] = GW[tk_ * 128 + lane]; sc[1] = GW[tk_ * 128 + 64 + lane]; }
            int eA_lo, eA_hi, eB_lo, eB_hi;
            u32x4 tqA[16], tqB[16]; float scA[2], scB[2];
            auto consume = [&](const u32x4 (&tq)[16], const float (&sc)[2], const int n) __attribute__((always_inline)) {
                f32x2 acc[8];
#pragma unroll
                for (int j = 0; j < 8; ++j) acc[j] = (f32x2){0.f, 0.f};
#pragma unroll
                for (int i = 0; i < 16; ++i) {
                    const float we = __shfl(i < 8 ? sc[0] : sc[1], (i * 8 + grp) & 63);
                    FP8_PAIRS(tq[i], vp);
                    const f32x2 w2 = (f32x2){we, we};
#pragma unroll
                    for (int j = 0; j < 8; ++j) acc[j] = vp[j] * w2 + acc[j];
                }
                f32x2 r4[4], r2[2], r1;
#pragma unroll
                for (int j = 0; j < 4; ++j) { const f32x2 keep = b0 ? acc[4 + j] : acc[j], give = b0 ? acc[j] : acc[4 + j];
                    r4[j].x = keep.x + __shfl_xor(give.x, 8); r4[j].y = keep.y + __shfl_xor(give.y, 8); }
#pragma unroll
                for (int j = 0; j < 2; ++j) { const f32x2 keep = b1 ? r4[2 + j] : r4[j], give = b1 ? r4[j] : r4[2 + j];
                    r2[j].x = keep.x + __shfl_xor(give.x, 16); r2[j].y = keep.y + __shfl_xor(give.y, 16); }
                { const f32x2 keep = b2 ? r2[1] : r2[0], give = b2 ? r2[0] : r2[1];
                    r1.x = keep.x + __shfl_xor(give.x, 32); r1.y = keep.y + __shfl_xor(give.y, 32); }
                *(unsigned*)((bf16_t*)(p.ws + WS_PB) + (size_t)(tok0 + 8 * n) * 1024 + x * 128 + sub * 16 + 8 * (int)b0 + 4 * (int)b1 + 2 * (int)b2) = pk_bf16(r1.x, r1.y);
            };
            V_IDX(0, eA_lo, eA_hi);
            V_IDX(1, eB_lo, eB_hi);
            V_TBL(0, eA_lo, eA_hi, tqA, scA);
            for (int n = 0; n < NT; n += 2) {
                V_TBL(n + 1, eB_lo, eB_hi, tqB, scB);
                V_IDX(n + 2, eA_lo, eA_hi);
                consume(tqA, scA, n);
                V_TBL(n + 2, eA_lo, eA_hi, tqA, scA);
                V_IDX(n + 3, eB_lo, eB_hi);
                consume(tqB, scB, n + 1);
            }
#undef V_IDX
#undef V_TBL
        }
    }
}

DI void phase_ln3(const Params& p) {
    const bf16_t* X2B = (const bf16_t*)(p.ws + WS_XB);
    const float* g3 = p.in[I_LN3G]; const float* b3 = p.in[I_LN3B];
    const int lane = threadIdx.x & 63, w = threadIdx.x >> 6;
    for (int row = blockIdx.x * 8 + w; row < T; row += gridDim.x * 8) {
        float* yr = p.out + (size_t)row * 1024; const bf16_t* ys = (const bf16_t*)(p.ws + WS_PB) + (size_t)row * 1024; const bf16_t* xr = X2B + (size_t)row * 1024;
        f32x4 v[4]; float s = 0.f;
#pragma unroll
        for (int i = 0; i < 4; ++i) { const u32x2 ab = *(const u32x2*)(xr + i * 256 + lane * 4); f32x4 a; a[0] = bflo(ab.x); a[1] = bfhi(ab.x); a[2] = bflo(ab.y); a[3] = bfhi(ab.y); const u32x2 yb = *(const u32x2*)(ys + i * 256 + lane * 4); f32x4 y; y[0] = bflo(yb.x); y[1] = bfhi(yb.x); y[2] = bflo(yb.y); y[3] = bfhi(yb.y);
#pragma unroll
            for (int j = 0; j < 4; ++j) { v[i][j] = DN_ALPHA * a[j] + y[j]; s += v[i][j]; } }
#pragma unroll
        for (int o = 32; o >= 1; o >>= 1) s += __shfl_xor(s, o);
        const float mu = s * (1.f / 1024.f); float q = 0.f;
#pragma unroll
        for (int i = 0; i < 4; ++i)
#pragma unroll
            for (int j = 0; j < 4; ++j) { const float d = v[i][j] - mu; q += d * d; }
#pragma unroll
        for (int o = 32; o >= 1; o >>= 1) q += __shfl_xor(q, o);
        const float rs = rsqrtf(q * (1.f / 1024.f) + LN_EPS);
#pragma unroll
        for (int i = 0; i < 4; ++i) {
            const int c = i * 256 + lane * 4;
            const f32x4 gg = *(const f32x4*)(g3 + c), bb = *(const f32x4*)(b3 + c);
            f32x4 y;
#pragma unroll
            for (int j = 0; j < 4; ++j) y[j] = (v[i][j] - mu) * rs * gg[j] + bb[j];
            *(f32x4*)(yr + c) = y;
        }
    }
}

DI void run_phase(const Params& p, int ph, unsigned char* smem, int rep) {
    unsigned char* ws = p.ws;
    bf16_t* XS = (bf16_t*)(ws + WS_KB);
    switch (ph) {
    case 0: phase_prep(p, smem); break;
    case 1: phase_inproj(p, smem); break;
    case 2: break;
    case 3: if (rep == 0) phase_mix_a(p);
            phase_mix(p, smem, rep); break;
    case 4: phase_gemm1024<3>((const bf16_t*)(ws + WS_POOL), (const bf16_t*)(ws + WS_WCT), 512, nullptr, nullptr, (bf16_t*)(ws + WS_QB), (const bf16_t*)(ws + WS_EU), 1.f, smem);
            __syncthreads();
            phase_gemm1024<4>((const bf16_t*)p.out, (const bf16_t*)(ws + WS_WBAT), 1024, nullptr, nullptr, (bf16_t*)(ws + WS_QB), (const bf16_t*)(ws + WS_EV), 1.f, smem); break;
    case 5: break;
    case 6: phase_gemm1024<5>((const bf16_t*)(ws + WS_QB), (const bf16_t*)(ws + WS_WOUTT), 1024, nullptr, nullptr, XS, (const bf16_t*)(ws + WS_XB), 1.f, smem); break;
    case 7: phase_ln(XS, p.in[I_LN1G], p.in[I_LN1B], (bf16_t*)(ws + WS_XB)); break;
    case 8: { phase_gemm1024<1>((const bf16_t*)(ws + WS_XB), (const bf16_t*)(ws + WS_WCQT), 1024, nullptr, nullptr, (bf16_t*)(ws + WS_QB), nullptr, 0.0625f * LOG2E, smem);
              pg8::StaticOrder so; so.init(T, 1024, (int)gridDim.x, (int)blockIdx.x); pg8::Unit un;
              __syncthreads();
              if (so.next(0, un)) phase_xattn(p, smem, un.pm, un.pn); } break;
    case 9: break;
    case 10: phase_gemm1024<5>((const bf16_t*)(ws + WS_PB), (const bf16_t*)(ws + WS_WCOT), 1024, nullptr, nullptr, XS, (const bf16_t*)(ws + WS_XB), 1.f, smem); break;
    case 11: phase_ln(XS, p.in[I_LN2G], p.in[I_LN2B], (bf16_t*)(ws + WS_XB));
             cvt_rows_fp8(p.in[I_EU], ws + WS_EU, (float*)(ws + WS_SU)); cvt_rows_fp8(p.in[I_EV], ws + WS_EV, (float*)(ws + WS_SV)); break;
    case 12: { phase_gemm1024<2>((const bf16_t*)(ws + WS_XB), (const bf16_t*)(ws + WS_WPQT), 1024, nullptr, (float*)(ws + WS_PB), nullptr, nullptr, 1.f, smem);
               pg8::StaticOrder so; so.init(T, 1024, (int)gridDim.x, (int)blockIdx.x); pg8::Unit un;
               __syncthreads();
               if (so.next(0, un)) phase_route(p, smem, un.pm, un.pn); } break;
    case 13: break;
    case 14: phase_peer_u(p, smem, rep); break;
    case 15: phase_peer_w(p); break;
    case 16: phase_peer_v(p, smem, rep); break;
    case 17: phase_ln3(p); break;
    default: break;
    }
}

__global__ void __launch_bounds__(NTHR) fwd_megakernel(Params p) {
    extern __shared__ __attribute__((aligned(16))) unsigned char smem[];
    unsigned* bar = (unsigned*)(p.ws + WS_CTL + 16384);
    __shared__ uint4 xb_words;
    if (threadIdx.x == 0) xb_words = make_uint4(0u, 0u, 0u, 0u);
    __syncthreads();
    const XcdBarrier xb = xcd_barrier_post(bar, (volatile LAS unsigned*)&xb_words);
#define RUN_PH(n) if (p.ph_lo <= (n) && (n) < p.ph_hi) { for (int rep = 0; rep < ((n) == PROBE_DUP ? 2 : 1); ++rep) { run_phase(p, (n), smem, rep); \
        if ((n) + 1 < p.ph_hi || rep + 1 < ((n) == PROBE_DUP ? 2 : 1)) { if (p.use_cg) cg::this_grid().sync(); else xcd_barrier(xb); } } }
    RUN_PH(0) RUN_PH(1) RUN_PH(3) RUN_PH(4) RUN_PH(6) RUN_PH(7) RUN_PH(8) RUN_PH(10) RUN_PH(11) RUN_PH(12) RUN_PH(14) RUN_PH(15) RUN_PH(16) RUN_PH(17)
#undef RUN_PH
}

extern "C" void kernel_launch(void* const* d_in, const int* in_sizes, int n_in, void* d_out, int out_size, void* d_ws, size_t ws_size, hipStream_t stream) {
    static int grid = 0;
    if (grid == 0) {
        int dev = 0, cus = 0, per_cu = 0;
        hipGetDevice(&dev);
        hipDeviceGetAttribute(&cus, hipDeviceAttributeMultiprocessorCount, dev);
        if (hipFuncSetAttribute((const void*)fwd_megakernel, hipFuncAttributeMaxDynamicSharedMemorySize, LDS_BYTES) != hipSuccess) { fprintf(stderr, "hipFuncSetAttribute failed\n"); grid = -1; return; }
        if (hipOccupancyMaxActiveBlocksPerMultiprocessor(&per_cu, (const void*)fwd_megakernel, NTHR, LDS_BYTES) != hipSuccess || per_cu < 1) { fprintf(stderr, "occupancy query failed (%d)\n", per_cu); per_cu = 1; }
        (void)hipGetLastError();
        grid = cus * 1;
        if (n_in != 26 || ws_size < WS_END) { fprintf(stderr, "kernel_launch: unexpected n_in %d / ws_size %zu\n", n_in, ws_size); grid = -1; return; }
    }
    if (grid < 0) return;
    Params p{};
    for (int i = 0; i < 26; ++i) p.in[i] = (const float*)d_in[i];
    p.out = (float*)d_out; p.ws = (unsigned char*)d_ws; p.use_cg = 0; p.pad = 0;
    hipMemsetAsync((char*)d_ws + WS_CTL, 0, 32768, stream);
#if MK_MULTI
    for (int ph = 0; ph < NPHASE; ++ph) {
        p.ph_lo = ph; p.ph_hi = ph + 1;
        hipLaunchKernelGGL(fwd_megakernel, dim3(grid), dim3(NTHR), LDS_BYTES, stream, p);
    }
#else
    p.ph_lo = 0; p.ph_hi = NPHASE;
    void* args[] = {&p};
    hipError_t e = hipLaunchCooperativeKernel((const void*)fwd_megakernel, dim3(grid), dim3(NTHR), args, LDS_BYTES, stream);
    if (e != hipSuccess) fprintf(stderr, "cooperative launch failed: %s (grid %d)\n", hipGetErrorString(e), grid);
#endif
}
```

```cpp
#include <hip/hip_runtime.h>
#include <hip/hip_cooperative_groups.h>
#include <stdint.h>
#include <cstdio>
namespace cg = cooperative_groups;

#ifndef PROBE_DUP
#define PROBE_DUP -1
#endif
#ifndef MK_MULTI
#define MK_MULTI 0
#endif

#define DI __device__ __forceinline__
typedef unsigned short bf16_t;
typedef short bf16x8 __attribute__((ext_vector_type(8)));
typedef short s16x4 __attribute__((ext_vector_type(4)));
typedef float f32x16 __attribute__((ext_vector_type(16)));
typedef float f32x4 __attribute__((ext_vector_type(4)));
typedef unsigned u32x4 __attribute__((ext_vector_type(4)));
typedef unsigned u32x2 __attribute__((ext_vector_type(2)));
typedef __bf16 bf16x2 __attribute__((ext_vector_type(2)));
typedef float f32x2 __attribute__((ext_vector_type(2)));
#define MFMA32(a, b, c) __builtin_amdgcn_mfma_f32_32x32x16_bf16((a), (b), (c), 0, 0, 0)

constexpr int T = 16384, S = 8192, D = 1024;
constexpr int NTHR = 512;
constexpr int LDS_BYTES = 144 * 1024;
constexpr int NPHASE = 18;
constexpr float LOG2E = 1.4426950408889634f;
constexpr float DN_ALPHA = 1.189207115002721f;
constexpr float LN_EPS = 1e-5f;

constexpr size_t MB = 1024 * 1024;
constexpr size_t WS_CTL   = 0;
constexpr size_t WS_SU    = 65536;
constexpr size_t WS_SV    = 131072;
constexpr size_t WS_EU    = 1 * MB;
constexpr size_t WS_EV    = WS_EU + 32 * MB;
constexpr size_t WS_XB    = WS_EV + 32 * MB;
constexpr size_t WS_WINT  = WS_XB + 32 * MB;
constexpr size_t WS_WCT   = WS_WINT + 11 * MB;
constexpr size_t WS_WBAT  = WS_WCT + 1 * MB;
constexpr size_t WS_WOUTT = WS_WBAT + 2 * MB;
constexpr size_t WS_WCQT  = WS_WOUTT + 2 * MB;
constexpr size_t WS_WCKVT = WS_WCQT + 2 * MB;
constexpr size_t WS_WCOT  = WS_WCKVT + 4 * MB;
constexpr size_t WS_WPQT  = WS_WCOT + 2 * MB;
constexpr size_t WS_MEMB  = WS_WPQT + 2 * MB;
constexpr size_t WS_KC    = WS_MEMB + 1 * MB;
constexpr size_t WS_VCT   = WS_KC + 1 * MB;
constexpr size_t WS_KEYH  = WS_VCT + 1 * MB;
constexpr size_t WS_KEYL  = WS_KEYH + 256 * 1024;
constexpr size_t WS_PB    = WS_KEYL + 256 * 1024 + 512 * 1024;
constexpr size_t WS_POOL  = WS_PB + 16 * MB;
constexpr size_t WS_QB    = WS_POOL + 16 * MB;
constexpr size_t WS_KB    = WS_QB + 32 * MB;
constexpr size_t WS_VT    = WS_KB + 32 * MB;
constexpr size_t WS_END   = WS_VT + 32 * MB;
constexpr size_t WS_EIDX  = WS_WINT;
constexpr size_t WS_GW    = WS_WINT + 8 * MB;
static_assert(WS_END <= 256 * MB, "workspace overflow");
static_assert(WS_GW + 8 * MB <= WS_WPQT, "eidx/gw overlay");

struct Params {
    const float* in[26];
    float* out; unsigned char* ws;
    int ph_lo, ph_hi, use_cg, pad;
};
enum { I_X = 0, I_MEM, I_WIN, I_POOLW, I_POOLS, I_WBP, I_LQ1, I_LK1, I_LQ2, I_LK2, I_SUBLN, I_WBA, I_WOUT, I_LN1G, I_LN1B, I_WCQ, I_WCKV, I_WCO, I_LN2G, I_LN2B, I_WPQ, I_KEYS, I_EU, I_EV, I_LN3G, I_LN3B };

DI unsigned pk_bf16(float lo, float hi) { const f32x2 v = {lo, hi}; const bf16x2 b = __builtin_convertvector(v, bf16x2); return __builtin_bit_cast(unsigned, b); }
DI bf16_t f2bf(float x) { return (bf16_t)(pk_bf16(x, 0.f) & 0xffffu); }
DI float bf2f(unsigned short v) { return __uint_as_float(((unsigned)v) << 16); }
DI float bflo(unsigned v) { return __uint_as_float(v << 16); }
DI float bfhi(unsigned v) { return __uint_as_float(v & 0xffff0000u); }
DI int crow(int i, int hh) { return (i & 3) + 8 * (i >> 2) + 4 * hh; }
DI float fexp2(float x) { return __builtin_amdgcn_exp2f(x); }
DI float dot2(unsigned a, unsigned b, float acc) { return __builtin_amdgcn_fdot2_f32_bf16(__builtin_bit_cast(bf16x2, a), __builtin_bit_cast(bf16x2, b), acc, false); }
DI int swz(int r, int c) { return r * 128 + ((c ^ ((r >> 1) & 7)) << 4); }
DI int swp(int r, int c) { return r * 144 + (c << 4); }

#define XB_TMO      128
#define XB_XCNT(j)  (256  + 64 * (j))
#define XB_XSUB(j)  (1280 + 64 * (j))
#define XB_XGEN(j)  (2304 + 64 * (j))
#define XB_TOP      3328
#define XB_TOPGEN   3392
#define XCD_BAR_WORDS 3456
#define XB_SPIN_CAP (1u << 18)
#define LAS __attribute__((address_space(3)))

__device__ __forceinline__ unsigned xb_ld(unsigned* p)              { return __hip_atomic_load(p, __ATOMIC_RELAXED, __HIP_MEMORY_SCOPE_AGENT); }
__device__ __forceinline__ unsigned xb_add(unsigned* p, unsigned v) { return __hip_atomic_fetch_add(p, v, __ATOMIC_RELAXED, __HIP_MEMORY_SCOPE_AGENT); }
__device__ __forceinline__ unsigned xb_xcc_id() { return (unsigned)__builtin_amdgcn_s_getreg((3 << 11) | 20) & 0xFu; }
#define XB_SPIN(cond, bar) do { unsigned _sp = 0; while (cond) { __builtin_amdgcn_s_sleep(1); \
    if ((++_sp & 255u) == 0u) { if (xb_ld(&(bar)[XB_TMO])) break; if (_sp > XB_SPIN_CAP) { atomicAdd(&(bar)[XB_TMO], 1u); break; } } } } while (0)

struct XcdBarrier {
    unsigned* bar; unsigned x;
    volatile LAS unsigned* st;
};

__device__ __forceinline__ XcdBarrier xcd_barrier_post(unsigned* bar, volatile LAS unsigned* st) {
    XcdBarrier b; b.bar = bar; b.x = xb_xcc_id(); b.st = st;
    if (threadIdx.x == 0) (void)xb_add(&bar[XB_XCNT(b.x)], 1u);
    return b;
}
__device__ __forceinline__ void xcd_barrier_complete(unsigned* bar, unsigned x, unsigned& nloc, unsigned& nx) {
    const unsigned G = gridDim.x * gridDim.y * gridDim.z;
    unsigned sum, cnt, mine, sp = 0u;
    for (;;) {
        sum = 0u; cnt = 0u; mine = 0u;
#pragma unroll
        for (unsigned j = 0; j < 16; ++j) { const unsigned c = xb_ld(&bar[XB_XCNT(j)]); sum += c; cnt += (c > 0u) ? 1u : 0u; mine = (j == x) ? c : mine; }
        if (sum == G) break;
        __builtin_amdgcn_s_sleep(1);
        if ((++sp & 255u) == 0u) { if (xb_ld(&bar[XB_TMO])) break; if (sp > XB_SPIN_CAP) { atomicAdd(&bar[XB_TMO], 1u); break; } }
    }
    nloc = mine > 0u ? mine : 1u; nx = cnt > 0u ? cnt : 1u;
}

__device__ __forceinline__ void xcd_barrier(const XcdBarrier& b) {
    asm volatile("s_waitcnt vmcnt(0)" ::: "memory");
    __syncthreads();
    if (threadIdx.x == 0) {
        unsigned* bar = b.bar;
        __builtin_amdgcn_s_waitcnt(0);
        unsigned nloc = b.st[0], nx = b.st[1];
        if (nloc == 0u) { xcd_barrier_complete(bar, b.x, nloc, nx); b.st[0] = nloc; b.st[1] = nx; }
        const unsigned old = xb_add(&bar[XB_XSUB(b.x)], 1u);
        const unsigned gen = old / nloc;
        if (old + 1u == (gen + 1u) * nloc) {
            __builtin_amdgcn_fence(__ATOMIC_RELEASE, "agent");
            asm volatile("s_waitcnt vmcnt(0)" ::: "memory");
            const unsigned og = xb_add(&bar[XB_TOP], 1u);
            const unsigned tg = og / nx;
            if (og + 1u == (tg + 1u) * nx) xb_add(&bar[XB_TOPGEN], 1u);
            else XB_SPIN(xb_ld(&bar[XB_TOPGEN]) == tg, bar);
            __builtin_amdgcn_fence(__ATOMIC_ACQUIRE, "agent");
            xb_add(&bar[XB_XGEN(b.x)], 1u);
            asm volatile("s_waitcnt vmcnt(0)" ::: "memory");
        } else {
            XB_SPIN(xb_ld(&bar[XB_XGEN(b.x)]) == gen, bar);
            __builtin_amdgcn_fence(__ATOMIC_ACQUIRE, "agent");
            asm volatile("s_waitcnt vmcnt(0)" ::: "memory");
        }
    }
    __syncthreads();
}


namespace pg8 {
#define PG8_LAS __attribute__((address_space(3)))
typedef unsigned short bf16_t;
typedef short bf16x8 __attribute__((ext_vector_type(8)));
typedef float f32x4 __attribute__((ext_vector_type(4)));
typedef unsigned u32x4 __attribute__((ext_vector_type(4)));
constexpr int BM = 256, BK = 64, HALF = 128, HTB = HALF * BK * 2  , STAGE_BYTES = 8 * HTB, NXCD = 8, WGM = 8;

__host__ __device__ __forceinline__ int lds_byte(int r, int c) { const int st = (r >> 4) * 2 + (c >> 5), rr = r & 15, cc = c & 31, ob = rr * 64 + cc * 2; return st * 1024 + (ob ^ (((ob >> 9) & 1) << 5)); }
__host__ __device__ __forceinline__ void stage_rc(int b, int& R, int& C) { const int st = b / 1024, sb = b % 1024, swz = sb ^ (((sb >> 9) & 1) << 5); R = (st >> 1) * 16 + swz / 64; C = (st & 1) * 32 + (swz % 64) / 2; }
__host__ __device__ __forceinline__ int perm32(int rho) { const int n = rho >> 4, i = rho & 15; return 8 * (i >> 2) + 4 * n + (i & 3); }

struct Unit { int pm, pn; };
struct Gemm { const bf16_t* A; const bf16_t* Bt; int M, N, K; };

struct StaticOrder {
    int nM, nN, nwg, G, c;
    __host__ __device__ void init(int M, int N, int G_, int c_) { nM = M / BM; nN = N / BM; nwg = nM * nN; G = G_; c = c_; }
    __host__ __device__ bool next(int i, Unit& u) const {
        const long L = (long)i * G + c; if (L >= nwg) return false;
        int wgid = (int)L; { const int q = nwg / NXCD, r = nwg % NXCD, xcd = wgid % NXCD, off = wgid / NXCD; wgid = (xcd < r ? xcd * (q + 1) : r * (q + 1) + (xcd - r) * q) + off; }
        const int nig = WGM * nN, gid = wgid / nig, fm = gid * WGM, gsz = (nM - fm) < WGM ? (nM - fm) : WGM;
        u.pm = fm + ((wgid % nig) % gsz); u.pn = (wgid % nig) / gsz; return true;
    }
    __device__ __forceinline__ void a_ready(const Unit&) const {}
    __device__ __forceinline__ void done(const Unit&) const {}
};
template <class Epi, class Sched, bool ALIGN_EPI = false, bool SP2 = false>
__device__ __forceinline__ void gemm_phase(PG8_LAS unsigned char* lds, const Gemm g, const Sched& S, const Epi& E) {
    const int tid = threadIdx.x, wid = __builtin_amdgcn_readfirstlane(tid >> 6), lane = tid & 63, wr = wid >> 2, wc = wid & 3, fr = lane & 15, fq = lane >> 4;
    const int K = g.K, nt = K / BK;
    unsigned voffA[2], voffB[2];
#pragma unroll
    for (int i = 0; i < 2; ++i) { int R, C; stage_rc(tid * 16 + i * 8192, R, C); const int Rb = Epi::PERM ? ((R & ~31) + perm32(R & 31)) : R;
        voffA[i] = (unsigned)(R * K + C) * 2u; voffB[i] = (unsigned)(Rb * K + C) * 2u; }
    const size_t kstep = (size_t)(BK * 2);
    const size_t hstep = (size_t)HALF * K * 2;
    const size_t tstep = 2 * hstep;
    const unsigned ldsw = (unsigned)wid * 1024u;
    const int aoff = lds_byte(wr * 64 + fr, fq * 8), boff = lds_byte(wc * 32 + fr, fq * 8);
#define PG8_SA(b, h) (((b) * 2 + (h)) * HTB)
#define PG8_SB(b, h) ((4 + (b) * 2 + (h)) * HTB)
#define PG8_STAGE(bufoff, gbase, voff) do { _Pragma("unroll") for (int _i = 0; _i < 2; ++_i) \
        __builtin_amdgcn_global_load_lds((const unsigned*)((const char*)(gbase) + (voff)[_i]), (PG8_LAS unsigned*)(lds + (bufoff) + ldsw + _i * 8192), 16, 0, 0); } while (0)
#define PG8_LDA(dst, b, h) do { _Pragma("unroll") for (int m = 0; m < 4; ++m) _Pragma("unroll") for (int k = 0; k < 2; ++k) dst[m][k] = *(const PG8_LAS bf16x8*)(lds + PG8_SA(b, h) + aoff + m * 2048 + k * 1024); } while (0)
#define PG8_LDB(dst, b, h) do { _Pragma("unroll") for (int n = 0; n < 2; ++n) _Pragma("unroll") for (int k = 0; k < 2; ++k) dst[n][k] = *(const PG8_LAS bf16x8*)(lds + PG8_SB(b, h) + boff + n * 2048 + k * 1024); } while (0)
#define PG8_MMA(ai, bj, At, Bt) do { __builtin_amdgcn_s_setprio(1); _Pragma("unroll") for (int m = 0; m < 4; ++m) _Pragma("unroll") for (int n = 0; n < 2; ++n) _Pragma("unroll") for (int k = 0; k < 2; ++k) \
        acc[ai][bj][m][n] = __builtin_amdgcn_mfma_f32_16x16x32_bf16(Bt[n][k], At[m][k], acc[ai][bj][m][n], 0, 0, 0); __builtin_amdgcn_s_setprio(0); } while (0)
#define PG8_WAIT_V(n) asm volatile("s_waitcnt vmcnt(" #n ")" ::: "memory")
#define PG8_WAIT_L(n) asm volatile("s_waitcnt lgkmcnt(" #n ")" ::: "memory")
#define PG8_BAR __builtin_amdgcn_s_barrier()
#define PG8_SCHED __builtin_amdgcn_sched_barrier(0)
    Unit cur, nxt; int ui = 0;
    if (!S.next(0, cur)) return;
    f32x4 acc[2][2][4][2];
#pragma unroll
    for (int a = 0; a < 2; ++a)
#pragma unroll
        for (int b = 0; b < 2; ++b)
#pragma unroll
            for (int m = 0; m < 4; ++m)
#pragma unroll
                for (int n = 0; n < 2; ++n) acc[a][b][m][n] = (f32x4){0.f, 0.f, 0.f, 0.f};
    bf16x8 At[4][2], B0[2][2], B1[2][2];
    const char* cA = (const char*)g.A + (size_t)cur.pm * tstep; const char* cB = (const char*)g.Bt + (size_t)cur.pn * tstep;
    S.a_ready(cur);
    if constexpr (SP2) {
        PG8_STAGE(PG8_SB(0, 0), cB, voffB); PG8_STAGE(PG8_SB(0, 1), cB + hstep, voffB); PG8_STAGE(PG8_SA(0, 0), cA, voffA); PG8_STAGE(PG8_SA(0, 1), cA + hstep, voffA);
        if (wr == 1) PG8_BAR;
        PG8_WAIT_V(2); PG8_BAR;
        PG8_STAGE(PG8_SB(1, 0), cB + kstep, voffB); PG8_STAGE(PG8_SA(1, 0), cA + kstep, voffA); PG8_STAGE(PG8_SB(1, 1), cB + hstep + kstep, voffB);
        PG8_WAIT_V(6); PG8_BAR;
    } else {
        PG8_STAGE(PG8_SB(0, 0), cB, voffB); PG8_STAGE(PG8_SA(0, 0), cA, voffA); PG8_STAGE(PG8_SB(0, 1), cB + hstep, voffB); PG8_STAGE(PG8_SA(0, 1), cA + hstep, voffA);
        if (wr == 1) PG8_BAR;
        PG8_WAIT_V(4); PG8_BAR;
        PG8_STAGE(PG8_SB(1, 0), cB + kstep, voffB); PG8_STAGE(PG8_SA(1, 0), cA + kstep, voffA); PG8_STAGE(PG8_SB(1, 1), cB + hstep + kstep, voffB);
        PG8_WAIT_V(6); PG8_BAR;
    }
    for (;;) {
        const bool has_next = S.next(ui + 1, nxt);
        const char* nA = has_next ? (const char*)g.A + (size_t)nxt.pm * tstep : cA; const char* nB = has_next ? (const char*)g.Bt + (size_t)nxt.pn * tstep : cB;
        for (int t = 0; t < nt; t += 2) {
            const bool last = (t == nt - 2);
            const char* a1 = cA + (size_t)(t + 1) * kstep;
            const char* a2 = last ? nA : cA + (size_t)(t + 2) * kstep; const char* b2 = last ? nB : cB + (size_t)(t + 2) * kstep;
            const char* a3 = a2 + kstep; const char* b3 = b2 + kstep;
            if (last && has_next) S.a_ready(nxt);
            if constexpr (SP2) {
            PG8_LDB(B0, 0, 0); PG8_LDB(B1, 0, 1); PG8_SCHED; PG8_LDA(At, 0, 0); PG8_STAGE(PG8_SA(1, 1), a1 + hstep, voffA);
            PG8_WAIT_V(8); PG8_WAIT_L(0); PG8_BAR; PG8_MMA(0, 0, At, B0); PG8_MMA(0, 1, At, B1); PG8_BAR; PG8_SCHED;
            PG8_LDA(At, 0, 1); PG8_STAGE(PG8_SB(0, 0), b2, voffB); PG8_STAGE(PG8_SB(0, 1), b2 + hstep, voffB); PG8_STAGE(PG8_SA(0, 0), a2, voffA);
            PG8_WAIT_V(8); PG8_WAIT_L(0); PG8_BAR; PG8_MMA(1, 0, At, B0); PG8_MMA(1, 1, At, B1); PG8_BAR; PG8_SCHED;
            PG8_LDB(B0, 1, 0); PG8_LDB(B1, 1, 1); PG8_SCHED; PG8_LDA(At, 1, 0); PG8_STAGE(PG8_SA(0, 1), a2 + hstep, voffA);
            PG8_WAIT_V(8); PG8_WAIT_L(0); PG8_BAR; PG8_MMA(0, 0, At, B0); PG8_MMA(0, 1, At, B1); PG8_BAR; PG8_SCHED;
            PG8_LDA(At, 1, 1); PG8_STAGE(PG8_SB(1, 0), b3, voffB); PG8_STAGE(PG8_SB(1, 1), b3 + hstep, voffB); PG8_STAGE(PG8_SA(1, 0), a3, voffA);
            PG8_WAIT_V(8); PG8_WAIT_L(0); PG8_BAR; PG8_MMA(1, 0, At, B0); PG8_MMA(1, 1, At, B1); PG8_BAR; PG8_SCHED;
            } else {
            PG8_LDB(B0, 0, 0); PG8_SCHED; PG8_LDA(At, 0, 0); PG8_STAGE(PG8_SA(1, 1), a1 + hstep, voffA);
            PG8_WAIT_L(8); PG8_BAR; PG8_WAIT_L(0); PG8_MMA(0, 0, At, B0); PG8_BAR; PG8_SCHED;
            PG8_LDB(B1, 0, 1); PG8_STAGE(PG8_SB(0, 0), b2, voffB);
            PG8_BAR; PG8_WAIT_L(0); PG8_MMA(0, 1, At, B1); PG8_BAR;
            PG8_LDA(At, 0, 1); PG8_STAGE(PG8_SA(0, 0), a2, voffA);
            PG8_BAR; PG8_WAIT_L(0); PG8_MMA(1, 0, At, B0); PG8_BAR; PG8_SCHED;
            PG8_STAGE(PG8_SB(0, 1), b2 + hstep, voffB);
            PG8_WAIT_V(6); PG8_BAR; PG8_MMA(1, 1, At, B1); PG8_BAR;
            PG8_LDB(B0, 1, 0); PG8_SCHED; PG8_LDA(At, 1, 0); PG8_STAGE(PG8_SA(0, 1), a2 + hstep, voffA);
            PG8_WAIT_L(8); PG8_BAR; PG8_WAIT_L(0); PG8_MMA(0, 0, At, B0); PG8_BAR; PG8_SCHED;
            PG8_LDB(B1, 1, 1); PG8_STAGE(PG8_SB(1, 0), b3, voffB);
            PG8_BAR; PG8_WAIT_L(0); PG8_MMA(0, 1, At, B1); PG8_BAR;
            PG8_LDA(At, 1, 1); PG8_STAGE(PG8_SA(1, 0), a3, voffA);
            PG8_BAR; PG8_WAIT_L(0); PG8_MMA(1, 0, At, B0); PG8_BAR; PG8_SCHED;
            PG8_STAGE(PG8_SB(1, 1), b3 + hstep, voffB);
            PG8_WAIT_V(6); PG8_BAR; PG8_MMA(1, 1, At, B1); PG8_BAR;
            }
        }
        if constexpr (ALIGN_EPI) { if (wr == 0) PG8_BAR; }
        if constexpr (!Epi::AFTER_DRAIN) { E(acc, cur, wr, wc, fr, fq); S.done(cur); }
        if (!has_next) break;
#pragma unroll
        for (int a = 0; a < 2; ++a)
#pragma unroll
            for (int b = 0; b < 2; ++b)
#pragma unroll
                for (int m = 0; m < 4; ++m)
#pragma unroll
                    for (int n = 0; n < 2; ++n) acc[a][b][m][n] = (f32x4){0.f, 0.f, 0.f, 0.f};
        cur = nxt; cA = nA; cB = nB; ++ui;
        if constexpr (ALIGN_EPI) { if (wr == 1) PG8_BAR; }
    }
    PG8_WAIT_V(0);
    if constexpr (!ALIGN_EPI) { if (wr == 0) PG8_BAR; }
    PG8_BAR;
    if constexpr (Epi::AFTER_DRAIN) { E.fused(acc, cur, wr, wc, fr, fq, lds, wid, lane); S.done(cur); }
#undef PG8_SA
#undef PG8_SB
#undef PG8_STAGE
#undef PG8_LDA
#undef PG8_LDB
#undef PG8_MMA
#undef PG8_WAIT_V
#undef PG8_WAIT_L
#undef PG8_BAR
#undef PG8_SCHED
}
}

DI void cvt_rows(const float* __restrict__ src, bf16_t* __restrict__ dst, size_t n8) {
    for (size_t i = (size_t)blockIdx.x * NTHR + threadIdx.x; i < n8; i += (size_t)gridDim.x * NTHR) {
        const f32x4 a = *(const f32x4*)(src + i * 8), b = *(const f32x4*)(src + i * 8 + 4);
        u32x4 o; o.x = pk_bf16(a[0], a[1]); o.y = pk_bf16(a[2], a[3]); o.z = pk_bf16(b[0], b[1]); o.w = pk_bf16(b[2], b[3]);
        *(u32x4*)(dst + i * 8) = o;
    }
}
DI void cvt_rows_fp8(const float* __restrict__ src, unsigned char* __restrict__ dst, float* __restrict__ inv) {
    const int lane = threadIdx.x & 63, w = threadIdx.x >> 6;
    for (int r0 = (blockIdx.x * 8 + w) * 2; r0 < 16384; r0 += gridDim.x * 16) {
        f32x4 v[2][4]; float m[2] = {0.f, 0.f};
#pragma unroll
        for (int k = 0; k < 2; ++k)
#pragma unroll
            for (int i = 0; i < 4; ++i) v[k][i] = *(const f32x4*)(src + (size_t)(r0 + k) * 1024 + lane * 16 + i * 4);
#pragma unroll
        for (int k = 0; k < 2; ++k) {
#pragma unroll
            for (int i = 0; i < 4; ++i) m[k] = fmaxf(m[k], fmaxf(fmaxf(fabsf(v[k][i][0]), fabsf(v[k][i][1])), fmaxf(fabsf(v[k][i][2]), fabsf(v[k][i][3]))));
#pragma unroll
            for (int o = 32; o >= 1; o >>= 1) m[k] = fmaxf(m[k], __shfl_xor(m[k], o));
            const float sc = m[k] > 0.f ? 448.f / m[k] : 1.f;
            u32x4 q;
#pragma unroll
            for (int i = 0; i < 4; ++i) { int wd = 0; wd = __builtin_amdgcn_cvt_pk_fp8_f32(v[k][i][0] * sc, v[k][i][1] * sc, wd, false); wd = __builtin_amdgcn_cvt_pk_fp8_f32(v[k][i][2] * sc, v[k][i][3] * sc, wd, true); q[i] = (unsigned)wd; }
            *(u32x4*)(dst + (size_t)(r0 + k) * 1024 + lane * 16) = q;
            if (lane == 0) inv[r0 + k] = m[k] > 0.f ? m[k] / 448.f : 1.f;
        }
    }
}
DI void transpose_cvt(const float* __restrict__ src, int K, int N, bf16_t* __restrict__ dst, unsigned char* smem) {
    float* tl = (float*)smem;
    const int tk = K / 64, tn = N / 64, t = threadIdx.x;
    for (int tile = blockIdx.x; tile < tk * tn; tile += gridDim.x) {
        const int k0 = (tile / tn) * 64, n0 = (tile % tn) * 64;
#pragma unroll
        for (int i = 0; i < 8; ++i) { const int id = t + 512 * i, kk = id >> 6, nn = id & 63; tl[kk * 65 + nn] = src[(size_t)(k0 + kk) * N + n0 + nn]; }
        __syncthreads();
#pragma unroll
        for (int i = 0; i < 4; ++i) { const int id = t + 512 * i, nn = id >> 5, kp = id & 31;
            *(unsigned*)(dst + (size_t)(n0 + nn) * K + k0 + 2 * kp) = pk_bf16(tl[(2 * kp) * 65 + nn], tl[(2 * kp + 1) * 65 + nn]); }
        __syncthreads();
    }
}
DI void phase_prep(const Params& p, unsigned char* smem) {
    unsigned char* ws = p.ws;
    cvt_rows(p.in[I_X], (bf16_t*)(ws + WS_XB), (size_t)T * D / 8);
    cvt_rows(p.in[I_MEM], (bf16_t*)(ws + WS_MEMB), (size_t)512 * 1024 / 8);
    transpose_cvt(p.in[I_WIN], 1024, 5632, (bf16_t*)(ws + WS_WINT), smem);
    transpose_cvt(p.in[I_WBA], 1024, 1024, (bf16_t*)(ws + WS_WBAT), smem);
    transpose_cvt(p.in[I_WOUT], 1024, 1024, (bf16_t*)(ws + WS_WOUTT), smem);
    transpose_cvt(p.in[I_WCQ], 1024, 1024, (bf16_t*)(ws + WS_WCQT), smem);
    transpose_cvt(p.in[I_WCKV], 1024, 2048, (bf16_t*)(ws + WS_WCKVT), smem);
    transpose_cvt(p.in[I_WCO], 1024, 1024, (bf16_t*)(ws + WS_WCOT), smem);
    transpose_cvt(p.in[I_WPQ], 1024, 1024, (bf16_t*)(ws + WS_WPQT), smem);
    {
        const float* pw = p.in[I_POOLW]; const float* ps = p.in[I_POOLS]; const float* wb = p.in[I_WBP];
        bf16_t* wct = (bf16_t*)(ws + WS_WCT);
        float* coef = (float*)smem;
        for (int gc = blockIdx.x; gc < 512; gc += gridDim.x) {
            const int g = gc >> 7;
            __syncthreads();
            if (threadIdx.x < 128) coef[threadIdx.x] = pw[(size_t)gc * 128 + threadIdx.x] * ps[g * 128 + threadIdx.x];
            __syncthreads();
            const float* wp = wb + (size_t)(g * 128) * 1024 + threadIdx.x * 2;
            f32x2 acc = {0.f, 0.f};
#pragma unroll 16
            for (int d = 0; d < 128; ++d) { const f32x2 v = *(const f32x2*)(wp + (size_t)d * 1024); const float c = coef[d]; acc.x += c * v.x; acc.y += c * v.y; }
            wct[(size_t)(threadIdx.x * 2) * 512 + gc] = f2bf(acc.x); wct[(size_t)(threadIdx.x * 2 + 1) * 512 + gc] = f2bf(acc.y);
        }
        __syncthreads();
    }
    {
        const float* sk = p.in[I_KEYS]; bf16_t* kh = (bf16_t*)(ws + WS_KEYH); bf16_t* kl = (bf16_t*)(ws + WS_KEYL);
        for (int i = blockIdx.x * NTHR + threadIdx.x; i < 131072; i += gridDim.x * NTHR) {
            const float v = sk[i]; const bf16_t h = f2bf(v); kh[i] = h; kl[i] = f2bf(v - bf2f(h));
        }
    }
    if (blockIdx.x == 0 && threadIdx.x < 192) ((unsigned*)(ws + WS_CTL))[64 + threadIdx.x] = 0u;
}

#define EPI_FOREACH(...) _Pragma("unroll") for (int ai = 0; ai < 2; ++ai) _Pragma("unroll") for (int m = 0; m < 4; ++m) _Pragma("unroll") for (int bj = 0; bj < 2; ++bj) { \
        const int r = u.pm * 256 + ai * 128 + wr * 64 + m * 16 + fr, c = u.pn * 256 + bj * 128 + wc * 32 + 8 * fq; const f32x4 v0 = acc[ai][bj][m][0], v1 = acc[ai][bj][m][1]; __VA_ARGS__ }
DI u32x4 pk8(const f32x4 a, const f32x4 b) { u32x4 o; o.x = pk_bf16(a[0], a[1]); o.y = pk_bf16(a[2], a[3]); o.z = pk_bf16(b[0], b[1]); o.w = pk_bf16(b[2], b[3]); return o; }

struct EpiInproj {
    static constexpr bool PERM = true, AFTER_DRAIN = false;
    unsigned char* ws; bf16_t* gates;
    DI void operator()(const f32x4 (&acc)[2][2][4][2], const pg8::Unit& u, int wr, int wc, int fr, int fq) const {
        const int col0 = u.pn * 256;
        if (col0 < 512) { bf16_t* o = (bf16_t*)(ws + WS_PB); EPI_FOREACH({ *(u32x4*)(o + (size_t)r * 512 + c) = pk8(v0, v1); }) }
        else if (col0 < 2560) {
            const bool isq = col0 < 1536; const int cb = isq ? 512 : 1536; const float sc = isq ? 0.125f * LOG2E : 1.f;
            bf16_t* o = (bf16_t*)(ws + (isq ? WS_QB : WS_KB)) - cb;
            float mxs[2] = {0.f, 0.f};
            EPI_FOREACH({ const f32x4 a0 = v0 * sc; const f32x4 a1 = v1 * sc; *(u32x4*)(o + (size_t)r * 1024 + c) = pk8(a0, a1);
                float ss = (a0[0] * a0[0] + a0[1] * a0[1]) + (a0[2] * a0[2] + a0[3] * a0[3]) + (a1[0] * a1[0] + a1[1] * a1[1]) + (a1[2] * a1[2] + a1[3] * a1[3]);
                ss += __shfl_xor(ss, 16); ss += __shfl_xor(ss, 32);
                mxs[bj] = fmaxf(mxs[bj], ss); })
            unsigned* nm = (unsigned*)(ws + WS_CTL) + 128 + (isq ? 0 : 32);
#pragma unroll
            for (int bj = 0; bj < 2; ++bj) {
                float m = mxs[bj];
                m = fmaxf(m, __shfl_xor(m, 1)); m = fmaxf(m, __shfl_xor(m, 2)); m = fmaxf(m, __shfl_xor(m, 4)); m = fmaxf(m, __shfl_xor(m, 8));
                if ((threadIdx.x & 63) == 0) atomicMax(nm + ((col0 - cb + 128 * bj + 32 * wc) >> 5), __float_as_uint(m));
            }
        }
        else if (col0 < 3584) { bf16_t* o = (bf16_t*)(ws + WS_VT); EPI_FOREACH({ const int bb = r >> 13, ss = r & 8191, cc = c - 2560; _Pragma("unroll") for (int k = 0; k < 4; ++k) { o[((size_t)(bb * 1024 + cc + k)) * S + ss] = f2bf(v0[k]); o[((size_t)(bb * 1024 + cc + 4 + k)) * S + ss] = f2bf(v1[k]); } }) }
        else { bf16_t* o = gates + (col0 < 4608 ? (ptrdiff_t)-3584 : (ptrdiff_t)((size_t)T * 1024 - 4608));
            EPI_FOREACH({ f32x4 g0, g1;
                _Pragma("unroll") for (int k = 0; k < 4; ++k) { g0[k] = __builtin_amdgcn_rcpf(1.f + __expf(-v0[k])); g1[k] = __builtin_amdgcn_rcpf(1.f + __expf(-v1[k])); }
                *(u32x4*)(o + (size_t)r * 1024 + c) = pk8(g0, g1); }) }
    }
};
struct EpiKv {
    static constexpr bool PERM = true, AFTER_DRAIN = false;
    unsigned char* ws;
    DI void operator()(const f32x4 (&acc)[2][2][4][2], const pg8::Unit& u, int wr, int wc, int fr, int fq) const {
        if (u.pn < 4) { bf16_t* o = (bf16_t*)(ws + WS_KC); float mxs[2] = {0.f, 0.f};
            EPI_FOREACH({ *(u32x4*)(o + (size_t)r * 1024 + c) = pk8(v0, v1);
                float ss = (v0[0] * v0[0] + v0[1] * v0[1]) + (v0[2] * v0[2] + v0[3] * v0[3]) + (v1[0] * v1[0] + v1[1] * v1[1]) + (v1[2] * v1[2] + v1[3] * v1[3]);
                ss += __shfl_xor(ss, 16); ss += __shfl_xor(ss, 32); mxs[bj] = fmaxf(mxs[bj], ss); })
            unsigned* nmk = (unsigned*)(ws + WS_CTL) + 128 + 64 + (u.pm * 4 + u.pn) * 8;
#pragma unroll
            for (int bj = 0; bj < 2; ++bj) { float m = mxs[bj];
                m = fmaxf(m, __shfl_xor(m, 1)); m = fmaxf(m, __shfl_xor(m, 2)); m = fmaxf(m, __shfl_xor(m, 4)); m = fmaxf(m, __shfl_xor(m, 8));
                if ((threadIdx.x & 63) == 0) atomicMax(nmk + 4 * bj + wc, __float_as_uint(m)); } }
        else { bf16_t* o = (bf16_t*)(ws + WS_VCT);
            EPI_FOREACH({ const int b = r >> 8, mm = r & 255, cc = c - 1024;
                _Pragma("unroll") for (int k = 0; k < 4; ++k) { o[((size_t)(b * 1024 + cc + k)) * 256 + mm] = f2bf(v0[k]); o[((size_t)(b * 1024 + cc + 4 + k)) * 256 + mm] = f2bf(v1[k]); } }) }
    }
};
template <int MODE> struct EpiN1024 {
    static constexpr bool PERM = true, AFTER_DRAIN = false;
    const float* resid; float* outf; bf16_t* outb; const bf16_t* gate; float scale;
    DI void operator()(const f32x4 (&acc)[2][2][4][2], const pg8::Unit& u, int wr, int wc, int fr, int fq) const {
        EPI_FOREACH({ const size_t o = (size_t)r * 1024 + c;
            if (MODE == 0) { const f32x4 x0 = *(const f32x4*)(resid + o), x1 = *(const f32x4*)(resid + o + 4); *(u32x4*)(outb + o) = pk8(x0 * DN_ALPHA + v0, x1 * DN_ALPHA + v1); }
            else if (MODE == 5) { const u32x4 g = *(const u32x4*)(gate + o); f32x4 x0, x1; x0[0] = bflo(g.x); x0[1] = bfhi(g.x); x0[2] = bflo(g.y); x0[3] = bfhi(g.y); x1[0] = bflo(g.z); x1[1] = bfhi(g.z); x1[2] = bflo(g.w); x1[3] = bfhi(g.w);
                *(u32x4*)(outb + o) = pk8(x0 * DN_ALPHA + v0, x1 * DN_ALPHA + v1); }
            else if (MODE == 1) *(u32x4*)(outb + o) = pk8(v0 * scale, v1 * scale);
            else if (MODE == 2) { *(f32x4*)(outf + o) = v0; *(f32x4*)(outf + o + 4) = v1; }
            else { const u32x4 g = *(const u32x4*)(gate + o); f32x4 y0, y1;
                y0[0] = v0[0] * bflo(g.x); y0[1] = v0[1] * bfhi(g.x); y0[2] = v0[2] * bflo(g.y); y0[3] = v0[3] * bfhi(g.y);
                y1[0] = v1[0] * bflo(g.z); y1[1] = v1[1] * bfhi(g.z); y1[2] = v1[2] * bflo(g.w); y1[3] = v1[3] * bfhi(g.w);
                if (MODE == 4) { const u32x4 mo = *(const u32x4*)(outb + o);
                    y0[0] += bflo(mo.x); y0[1] += bfhi(mo.x); y0[2] += bflo(mo.y); y0[3] += bfhi(mo.y); y1[0] += bflo(mo.z); y1[1] += bfhi(mo.z); y1[2] += bflo(mo.w); y1[3] += bfhi(mo.w); }
                *(u32x4*)(outb + o) = pk8(y0, y1); } })
    }
};
struct KvOrder {
    int c;
    DI bool next(int i, pg8::Unit& u) const { if (i != 0 || c < 128 || c >= 144) return false; const int j = c - 128; u.pm = j & 1; u.pn = j >> 1; return true; }
    DI void a_ready(const pg8::Unit&) const {}
    DI void done(const pg8::Unit&) const {}
};
#define LDS3(p) ((__attribute__((address_space(3))) unsigned char*)(p))

DI void phase_inproj(const Params& p, unsigned char* smem) {
    unsigned char* ws = p.ws;
    { pg8::Gemm g{(const bf16_t*)(ws + WS_XB), (const bf16_t*)(ws + WS_WINT), T, 5632, 1024}; pg8::StaticOrder so; so.init(T, 5632, (int)gridDim.x, (int)blockIdx.x);
      EpiInproj e{ws, (bf16_t*)(ws + WS_EU)};
      pg8::gemm_phase<EpiInproj, pg8::StaticOrder, true, true>(LDS3(smem), g, so, e); }
    __syncthreads();
    { pg8::Gemm g{(const bf16_t*)(ws + WS_MEMB), (const bf16_t*)(ws + WS_WCKVT), 512, 2048, 1024}; KvOrder ko{(int)blockIdx.x};
      EpiKv e{ws};
      pg8::gemm_phase<EpiKv, KvOrder, true, true>(LDS3(smem), g, ko, e); }
}

DI void pooled_pass(const Params& p) {
    const bf16_t* pb = (const bf16_t*)(p.ws + WS_PB); bf16_t* po = (bf16_t*)(p.ws + WS_POOL);
    for (int i = blockIdx.x * NTHR + threadIdx.x; i < T * 64; i += gridDim.x * NTHR) {
        const int tok = i >> 6, c8 = i & 63, s = tok & (S - 1), g = c8 >> 4, wnd = 2 << g;
        const int n = (s + 1 < wnd) ? s + 1 : wnd;
        float sum[8];
#pragma unroll
        for (int j = 0; j < 8; ++j) sum[j] = 0.f;
        u32x4 self;
        for (int k = 0; k < n; ++k) {
            const u32x4 v = *(const u32x4*)(pb + (size_t)(tok - k) * 512 + c8 * 8);
            if (k == 0) self = v;
            sum[0] += bflo(v.x); sum[1] += bfhi(v.x); sum[2] += bflo(v.y); sum[3] += bfhi(v.y); sum[4] += bflo(v.z); sum[5] += bfhi(v.z); sum[6] += bflo(v.w); sum[7] += bfhi(v.w);
        }
        const float inv = 1.f / (float)n;
        u32x4 o;
        o.x = pk_bf16(sum[0] * inv - bflo(self.x), sum[1] * inv - bfhi(self.x)); o.y = pk_bf16(sum[2] * inv - bflo(self.y), sum[3] * inv - bfhi(self.y));
        o.z = pk_bf16(sum[4] * inv - bflo(self.z), sum[5] * inv - bfhi(self.z)); o.w = pk_bf16(sum[6] * inv - bflo(self.w), sum[7] * inv - bfhi(self.w));
        *(u32x4*)(po + (size_t)tok * 512 + c8 * 8) = o;
    }
}

DI void attn_unit(const Params& p, int b, int h, int qb, int kt0, float mfix, float lam, unsigned char* smem) {
    const bf16_t* QB = (const bf16_t*)(p.ws + WS_QB); const bf16_t* KB = (const bf16_t*)(p.ws + WS_KB); const bf16_t* VT = (const bf16_t*)(p.ws + WS_VT);
    bf16_t* DA = (bf16_t*)(p.ws + WS_XB);
    const int t = threadIdx.x, lane = t & 63, w = t >> 6, map = w & 1, qg = w >> 1, hh = lane >> 5, ln = lane & 31;
    const int q0 = qb * 128, qpos = q0 + qg * 32 + ln;
    const float slope2 = exp2f(-(float)(h + 1)) * LOG2E;
    bf16x8 bq[4];
#pragma unroll
    for (int ks = 0; ks < 4; ++ks) bq[ks] = *(const bf16x8*)(QB + (size_t)(b * S + qpos) * 1024 + h * 128 + map * 64 + ks * 16 + hh * 8);
    f32x16 O[4];
#pragma unroll
    for (int k = 0; k < 4; ++k)
#pragma unroll
        for (int i = 0; i < 16; ++i) O[k][i] = 0.f;
    float l_run = 0.f;
    const int ntiles = 2 * qb + 2;
    u32x4 rk0[2], rv0[2], rk1[2], rv1[2];
#define A_LOAD(kt, rk, rv) { _Pragma("unroll") for (int i = 0; i < 2; ++i) { const int id = t + 512 * i, r = (id >> 3) & 63, c = id & 7; \
                         rk[i] = *(const u32x4*)(KB + (size_t)(b * S + (kt) * 64 + r) * 1024 + h * 128 + i * 64 + c * 8); } \
                     _Pragma("unroll") for (int i = 0; i < 2; ++i) { const int id = t + 512 * i, r = id >> 3, c = id & 7; \
                         rv[i] = *(const u32x4*)(VT + (size_t)((b * 8 + h) * 128 + r) * S + (kt) * 64 + c * 8); } }
#define A_STORE(buf, rk, rv) { unsigned char* sb_ = smem + (buf) * 36864; \
                     _Pragma("unroll") for (int i = 0; i < 2; ++i) { const int id = t + 512 * i, r = (id >> 3) & 63, c = id & 7; *(u32x4*)(sb_ + i * 9216 + swp(r, c)) = rk[i]; } \
                     _Pragma("unroll") for (int i = 0; i < 2; ++i) { const int id = t + 512 * i, r = id >> 3, c = id & 7; unsigned char* d_ = sb_ + 18432 + r * 144 + (c >> 1) * 32 + (c & 1) * 8; \
                         u32x2 lo_; lo_.x = rv[i].x; lo_.y = rv[i].y; u32x2 hi_; hi_.x = rv[i].z; hi_.y = rv[i].w; *(u32x2*)(d_) = lo_; *(u32x2*)(d_ + 16) = hi_; } }
    auto compute = [&](const int kt) __attribute__((always_inline)) {
        const int cur = kt & 1;
        const unsigned char* sK = smem + cur * 36864 + map * 9216;
        const unsigned char* sV = smem + cur * 36864 + 18432;
        const int koff = kt * 64 + 4 * hh;
        const float nmref = slope2 * (float)(koff - qpos) - mfix;
        f32x16 s[2];
#pragma unroll
        for (int sub = 0; sub < 2; ++sub)
#pragma unroll
            for (int i = 0; i < 16; ++i) s[sub][i] = fmaf(slope2, (float)(sub * 32 + (i & 3) + 8 * (i >> 2)), nmref);
        __builtin_amdgcn_s_setprio(1);
#pragma unroll
        for (int sub = 0; sub < 2; ++sub) {
#pragma unroll
            for (int ks = 0; ks < 4; ++ks) { const int r = sub * 32 + ln, c = 2 * ks + hh; const bf16x8 a = *(const bf16x8*)(sK + swp(r, c)); s[sub] = MFMA32(a, bq[ks], s[sub]); }
        }
        __builtin_amdgcn_s_setprio(0);
        float ps = 0.f;
        if (kt >= ntiles - 2) {
#pragma unroll
            for (int sub = 0; sub < 2; ++sub)
#pragma unroll
                for (int i = 0; i < 16; ++i) { const int c = sub * 32 + (i & 3) + 8 * (i >> 2); const float v = (c + koff > qpos) ? -1e30f : s[sub][i]; const float e = fexp2(v); s[sub][i] = e; ps += e; }
        } else {
#pragma unroll
            for (int sub = 0; sub < 2; ++sub)
#pragma unroll
                for (int i = 0; i < 16; ++i) { const float e = fexp2(s[sub][i]); s[sub][i] = e; ps += e; }
        }
        l_run += ps;
        bf16x8 pf[2][2];
#pragma unroll
        for (int sub = 0; sub < 2; ++sub)
#pragma unroll
            for (int st = 0; st < 2; ++st) {
                u32x4 q; q.x = pk_bf16(s[sub][8 * st], s[sub][8 * st + 1]); q.y = pk_bf16(s[sub][8 * st + 2], s[sub][8 * st + 3]);
                q.z = pk_bf16(s[sub][8 * st + 4], s[sub][8 * st + 5]); q.w = pk_bf16(s[sub][8 * st + 6], s[sub][8 * st + 7]);
                pf[sub][st] = __builtin_bit_cast(bf16x8, q);
            }
        __builtin_amdgcn_s_setprio(1);
#pragma unroll
        for (int blk = 0; blk < 4; ++blk)
#pragma unroll
            for (int sub = 0; sub < 2; ++sub)
#pragma unroll
                for (int st = 0; st < 2; ++st) {
                    const int r = blk * 32 + ln, ch = sub * 4 + 2 * st + hh;
                    const bf16x8 va = *(const bf16x8*)(sV + swp(r, ch));
                    O[blk] = MFMA32(va, pf[sub][st], O[blk]);
                }
        __builtin_amdgcn_s_setprio(0);
    };
    A_LOAD(kt0, rk0, rv0); A_STORE(kt0 & 1, rk0, rv0);
    if (kt0 + 1 < ntiles) A_LOAD(kt0 + 1, rk1, rv1);
    __syncthreads();
    for (int kt = kt0; kt < ntiles; kt += 2) {
        if (kt + 2 < ntiles) A_LOAD(kt + 2, rk0, rv0);
        compute(kt);
        if (kt + 1 < ntiles) A_STORE((kt + 1) & 1, rk1, rv1);
        __syncthreads();
        if (kt + 1 >= ntiles) break;
        if (kt + 3 < ntiles) A_LOAD(kt + 3, rk1, rv1);
        compute(kt + 1);
        if (kt + 2 < ntiles) A_STORE(kt & 1, rk0, rv0);
        __syncthreads();
    }
#undef A_LOAD
#undef A_STORE
    const float l_tot = l_run + __shfl_xor(l_run, 32), inv_l = 1.f / l_tot;
    float* ex = (float*)smem;
    if (map == 1) {
#pragma unroll
        for (int k = 0; k < 4; ++k)
#pragma unroll
            for (int i = 0; i < 16; ++i) ex[(qg * 64 + k * 16 + i) * 64 + lane] = O[k][i] * inv_l;
    }
    __syncthreads();
    if (map == 0) {
        float ssq = 0.f;
#pragma unroll
        for (int k = 0; k < 4; ++k)
#pragma unroll
            for (int i = 0; i < 16; ++i) { const float v = O[k][i] * inv_l - lam * ex[(qg * 64 + k * 16 + i) * 64 + lane]; O[k][i] = v; ssq += v * v; }
        ssq += __shfl_xor(ssq, 32);
        const float rs = rsqrtf(ssq * (1.f / 128.f) + LN_EPS) * 0.8f;
        const float* sw = p.in[I_SUBLN];
#pragma unroll
        for (int k = 0; k < 4; ++k)
#pragma unroll
            for (int g = 0; g < 4; ++g) {
                const int dv = k * 32 + 8 * g + 4 * hh;
                const f32x4 wv = *(const f32x4*)(sw + dv);
                u32x2 v; v.x = pk_bf16(O[k][4 * g] * rs * wv[0], O[k][4 * g + 1] * rs * wv[1]); v.y = pk_bf16(O[k][4 * g + 2] * rs * wv[2], O[k][4 * g + 3] * rs * wv[3]);
                *(u32x2*)(DA + (size_t)(b * S + qpos) * 1024 + h * 128 + dv) = v;
            }
    }
    __syncthreads();
}

DI void norm_pass(const Params& p) {
    unsigned* nm = (unsigned*)(p.ws + WS_CTL) + 128;
    const int t = threadIdx.x, chunk = t & 127, toff = t >> 7;
#pragma unroll
    for (int which = 0; which < 2; ++which) {
        const bf16_t* src = (const bf16_t*)(p.ws + (which ? WS_KB : WS_QB));
        float best = 0.f;
        for (int tok = blockIdx.x * 4 + toff; tok < T; tok += gridDim.x * 4) {
            const u32x4 v = *(const u32x4*)(src + (size_t)tok * 1024 + chunk * 8);
            float ss = bflo(v.x) * bflo(v.x) + bfhi(v.x) * bfhi(v.x) + bflo(v.y) * bflo(v.y) + bfhi(v.y) * bfhi(v.y)
                     + bflo(v.z) * bflo(v.z) + bfhi(v.z) * bfhi(v.z) + bflo(v.w) * bflo(v.w) + bfhi(v.w) * bfhi(v.w);
            ss += __shfl_xor(ss, 1); ss += __shfl_xor(ss, 2); ss += __shfl_xor(ss, 4);
            best = fmaxf(best, ss);
        }
        if ((t & 7) == 0) atomicMax(nm + which * 16 + (chunk >> 3), __float_as_uint(best));
    }
}
DI void phase_mix_a(const Params& p) { pooled_pass(p); }
DI void phase_mix(const Params& p, unsigned char* smem, int rep) {
    float lam;
    {
        float a = 0.f, c = 0.f;
        for (int i = 0; i < 64; ++i) { a += p.in[I_LQ1][i] * p.in[I_LK1][i]; c += p.in[I_LQ2][i] * p.in[I_LK2][i]; }
        lam = expf(a) - expf(c) + 0.2f;
    }
    const unsigned* nm = (const unsigned*)(p.ws + WS_CTL) + 128;
    unsigned* ctr = (unsigned*)(p.ws + WS_CTL) + 64 + rep;
    __shared__ int s_unit;
    for (;;) {
        if (threadIdx.x == 0) s_unit = (int)atomicAdd(ctr, 1u);
        __syncthreads();
        const int u = s_unit;
        __syncthreads();
        if (u >= 1024) break;
        const int qb = 63 - (u >> 4), bh = u & 15, h = bh & 7;
        const int g0 = 2 * (h * 2), g1 = 2 * (h * 2 + 1);
        const float bq0 = sqrtf((__uint_as_float(nm[g0]) + __uint_as_float(nm[g0 + 1])) * (__uint_as_float(nm[32 + g0]) + __uint_as_float(nm[32 + g0 + 1])));
        const float bq1 = sqrtf((__uint_as_float(nm[g1]) + __uint_as_float(nm[g1 + 1])) * (__uint_as_float(nm[32 + g1]) + __uint_as_float(nm[32 + g1 + 1])));
        const float bq = fmaxf(bq0, bq1) * 1.01f;
        const float slope2 = exp2f(-(float)(h + 1)) * LOG2E;
        const float dskip = (2.f * bq + 160.f) / slope2;
        int kt0 = 0;
        { const float lim = (float)(qb * 128 - 63) - dskip;
          if (lim > 0.f) kt0 = (int)ceilf(lim * (1.f / 64.f)); }
        if (kt0 > 2 * qb) kt0 = 2 * qb;
        attn_unit(p, bh >> 3, h, qb, kt0, bq, lam, smem);
    }
}

template <int MODE>
DI void phase_gemm1024(const bf16_t* A, const bf16_t* Bt, int K, const float* resid, float* outf, bf16_t* outb, const bf16_t* gate, float scale, unsigned char* smem) {
    pg8::Gemm g{A, Bt, T, 1024, K}; pg8::StaticOrder so; so.init(T, 1024, (int)gridDim.x, (int)blockIdx.x);
    EpiN1024<MODE> e{resid, outf, outb, gate, scale};
    pg8::gemm_phase<EpiN1024<MODE>, pg8::StaticOrder, true, true>(LDS3(smem), g, so, e);
}

DI void phase_ln(const bf16_t* xs, const float* g, const float* bta, bf16_t* outb) {
    const int lane = threadIdx.x & 63, w = threadIdx.x >> 6;
    for (int row = blockIdx.x * 8 + w; row < T; row += gridDim.x * 8) {
        const bf16_t* xr = xs + (size_t)row * 1024;
        f32x4 v[4]; float s = 0.f;
#pragma unroll
        for (int i = 0; i < 4; ++i) { const u32x2 xb = *(const u32x2*)(xr + i * 256 + lane * 4); v[i][0] = bflo(xb.x); v[i][1] = bfhi(xb.x); v[i][2] = bflo(xb.y); v[i][3] = bfhi(xb.y); s += (v[i][0] + v[i][1]) + (v[i][2] + v[i][3]); }
#pragma unroll
        for (int o = 32; o >= 1; o >>= 1) s += __shfl_xor(s, o);
        const float mu = s * (1.f / 1024.f); float q = 0.f;
#pragma unroll
        for (int i = 0; i < 4; ++i)
#pragma unroll
            for (int j = 0; j < 4; ++j) { const float d = v[i][j] - mu; q += d * d; }
#pragma unroll
        for (int o = 32; o >= 1; o >>= 1) q += __shfl_xor(q, o);
        const float rs = rsqrtf(q * (1.f / 1024.f) + LN_EPS);
#pragma unroll
        for (int i = 0; i < 4; ++i) {
            const int c = i * 256 + lane * 4;
            const f32x4 gg = *(const f32x4*)(g + c), bb = *(const f32x4*)(bta + c);
            f32x4 y;
#pragma unroll
            for (int j = 0; j < 4; ++j) y[j] = (v[i][j] - mu) * rs * gg[j] + bb[j];
            u32x2 ob; ob.x = pk_bf16(y[0], y[1]); ob.y = pk_bf16(y[2], y[3]);
            *(u32x2*)(outb + (size_t)row * 1024 + c) = ob;
        }
    }
}

DI int swz2(int r, int c) { return r * 528 + (c << 4); }
DI void phase_xattn(const Params& p, unsigned char* smem, int tile, int h) {
    const bf16_t* QC = (const bf16_t*)(p.ws + WS_QB); const bf16_t* KC = (const bf16_t*)(p.ws + WS_KC); const bf16_t* VCT = (const bf16_t*)(p.ws + WS_VCT);
    bf16_t* OC = (bf16_t*)(p.ws + WS_PB);
    const int t = threadIdx.x, lane = t & 63, w = t >> 6, hh = lane >> 5, ln = lane & 31;
    {
        const int tok0 = tile * 256, b = tok0 / S;
        const int tok = tok0 + w * 32 + ln;
        float kmax2 = 0.f;
        { const unsigned* nmk = (const unsigned*)(p.ws + WS_CTL) + 128 + 64 + (b * 4 + h) * 8;
#pragma unroll
          for (int j = 0; j < 8; ++j) kmax2 += __uint_as_float(nmk[j]); }
        u32x4 rr[4];
#define X_LOAD(st) { _Pragma("unroll") for (int i = 0; i < 4; ++i) { const int id = t + 512 * i, r = id >> 5, c = id & 31; \
                         rr[i] = ((st) < 4) ? *(const u32x4*)(KC + (size_t)(b * 256 + (st) * 64 + r) * 1024 + h * 256 + c * 8) \
                                            : *(const u32x4*)(VCT + (size_t)(b * 1024 + h * 256 + ((st) - 4) * 64 + r) * 256 + c * 8); } }
#define X_STORE(buf) { unsigned char* sb_ = smem + (buf) * 33792; _Pragma("unroll") for (int i = 0; i < 4; ++i) { const int id = t + 512 * i, r = id >> 5, c = id & 31; *(u32x4*)(sb_ + swz2(r, c)) = rr[i]; } }
        bf16x8 bqr[16];
        float qss = 0.f;
#pragma unroll
        for (int ks = 0; ks < 16; ++ks) {
            const u32x4 v = *(const u32x4*)(QC + (size_t)tok * 1024 + h * 256 + ks * 16 + hh * 8);
            qss += bflo(v.x) * bflo(v.x) + bfhi(v.x) * bfhi(v.x) + bflo(v.y) * bflo(v.y) + bfhi(v.y) * bfhi(v.y)
                 + bflo(v.z) * bflo(v.z) + bfhi(v.z) * bfhi(v.z) + bflo(v.w) * bflo(v.w) + bfhi(v.w) * bfhi(v.w);
            bqr[ks] = __builtin_bit_cast(bf16x8, v);
        }
        qss += __shfl_xor(qss, 32);
        const float nref = -1.01f * sqrtf(qss * kmax2);
        X_LOAD(0); X_STORE(0);
        __syncthreads();
        bf16x8 pf[8][2];
        float psum = 0.f, inv_l = 0.f;
#pragma unroll
        for (int st = 0; st < 8; ++st) {
            const int cur = st & 1;
            if (st + 1 < 8) X_LOAD(st + 1);
            const unsigned char* sb = smem + cur * 33792;
            if (st < 4) {
#pragma unroll
                for (int sub = 0; sub < 2; ++sub) {
                    f32x16 a16;
#pragma unroll
                    for (int i = 0; i < 16; ++i) a16[i] = nref;
#pragma unroll
                    for (int ks = 0; ks < 16; ++ks) {
                        const int r = sub * 32 + ln, c = 2 * ks + hh;
                        const bf16x8 a = *(const bf16x8*)(sb + swz2(r, c));
                        a16 = MFMA32(a, bqr[ks], a16);
                    }
#pragma unroll
                    for (int i = 0; i < 16; ++i) { a16[i] = fexp2(a16[i]); psum += a16[i]; }
#pragma unroll
                    for (int s2 = 0; s2 < 2; ++s2) {
                        u32x4 q; q.x = pk_bf16(a16[8 * s2], a16[8 * s2 + 1]); q.y = pk_bf16(a16[8 * s2 + 2], a16[8 * s2 + 3]);
                        q.z = pk_bf16(a16[8 * s2 + 4], a16[8 * s2 + 5]); q.w = pk_bf16(a16[8 * s2 + 6], a16[8 * s2 + 7]);
                        pf[st * 2 + sub][s2] = __builtin_bit_cast(bf16x8, q);
                    }
                }
                if (st == 3) { psum += __shfl_xor(psum, 32); inv_l = 1.f / psum; }
            } else {
#pragma unroll
                for (int blk = 0; blk < 2; ++blk) {
                    f32x16 o16;
#pragma unroll
                    for (int i = 0; i < 16; ++i) o16[i] = 0.f;
#pragma unroll
                    for (int k = 0; k < 8; ++k)
#pragma unroll
                        for (int s2 = 0; s2 < 2; ++s2) {
                            const int r = blk * 32 + ln, ch = k * 4 + 2 * s2;
                            const s16x4 lo = *(const s16x4*)(sb + swz2(r, ch) + 8 * hh), hi = *(const s16x4*)(sb + swz2(r, ch + 1) + 8 * hh);
                            const bf16x8 va = __builtin_shufflevector(lo, hi, 0, 1, 2, 3, 4, 5, 6, 7);
                            o16 = MFMA32(va, pf[k][s2], o16);
                        }
#pragma unroll
                    for (int g = 0; g < 4; ++g) {
                        const int dv = (st - 4) * 64 + blk * 32 + 8 * g + 4 * hh;
                        u32x2 v; v.x = pk_bf16(o16[4 * g] * inv_l, o16[4 * g + 1] * inv_l); v.y = pk_bf16(o16[4 * g + 2] * inv_l, o16[4 * g + 3] * inv_l);
                        *(u32x2*)(OC + (size_t)tok * 1024 + h * 256 + dv) = v;
                    }
                }
            }
            if (st + 1 < 8) X_STORE(cur ^ 1);
            __syncthreads();
        }
#undef X_LOAD
#undef X_STORE
    }
}

DI int sortable(float v) { int b = __float_as_int(v); return b ^ ((b >> 31) & 0x7fffffff); }
#define CE_DESC(a, b) { const int hi_ = max(a, b), lo_ = min(a, b); a = hi_; b = lo_; }
template <int N> DI void bitonic_sort_desc(int (&k)[N]) {
#pragma unroll
    for (int sz = 2; sz <= N; sz <<= 1)
#pragma unroll
        for (int j = sz >> 1; j > 0; j >>= 1)
#pragma unroll
            for (int i = 0; i < N; ++i) {
                const int l = i ^ j;
                if (l > i) { if ((i & sz) == 0) { CE_DESC(k[i], k[l]); } else { CE_DESC(k[l], k[i]); } }
            }
}
DI void merge_top16(int (&a)[16], const int (&b)[16]) {
#pragma unroll
    for (int i = 0; i < 16; ++i) a[i] = max(a[i], b[15 - i]);
#pragma unroll
    for (int j = 8; j > 0; j >>= 1)
#pragma unroll
        for (int i = 0; i < 16; ++i) { const int l = i ^ j; if (l > i) CE_DESC(a[i], a[l]); }
}
__constant__ unsigned char PEER_CAND[64] = {
    0x00,0x01,0x02,0x03,0x04,0x05,0x06,0x07,0x08,0x09,0x0a,0x0b,0x0c,0x0d,0x0e,0x0f,
    0x10,0x11,0x12,0x13,0x14,0x15,0x16,0x17, 0x20,0x21,0x22,0x23,0x24, 0x30,0x31,0x32,0x33, 0x40,0x41,0x42, 0x50,0x51, 0x60,0x61, 0x70,0x71,
    0x80,0x90,0xa0,0xb0,0xc0,0xd0,0xe0,0xf0,
    0xff,0xff,0xff,0xff,0xff,0xff,0xff,0xff,0xff,0xff,0xff,0xff,0xff,0xff };
DI void phase_route(const Params& p, unsigned char* smem, int pm, int pn) {
    const float* PQ = (const float*)(p.ws + WS_PB);
    const bf16_t* KH = (const bf16_t*)(p.ws + WS_KEYH); const bf16_t* KL = (const bf16_t*)(p.ws + WS_KEYL);
    int* EIDX = (int*)(p.ws + WS_EIDX); float* GW = (float*)(p.ws + WS_GW);
    constexpr int SCP = 132;
    float* sc = (float*)smem;
    float* lval = (float*)(smem + 64 * 2 * SCP * 4);
    int* lidx = (int*)(lval + 64 * 2 * 16);
    const int t = threadIdx.x, lane = t & 63, w = t >> 6, hh = lane >> 5, ln = lane & 31;
    for (int uu = 0; uu < 8; ++uu) {
        const int tile = pm * 4 + (uu >> 1), h = pn * 2 + (uu & 1), t0 = tile * 64;
        {
            const int c = w & 1, ts = (w >> 1) & 1, kh2 = w >> 2;
            const int tok = t0 + ts * 32 + ln;
            bf16x8 qh[4], ql[4];
#pragma unroll
            for (int ks = 0; ks < 4; ++ks) {
                const float* qp = PQ + (size_t)tok * 1024 + h * 128 + c * 64 + ks * 16 + hh * 8;
                const f32x4 a = *(const f32x4*)qp, bb = *(const f32x4*)(qp + 4);
                u32x4 hv, lv;
                hv.x = pk_bf16(a[0], a[1]); hv.y = pk_bf16(a[2], a[3]); hv.z = pk_bf16(bb[0], bb[1]); hv.w = pk_bf16(bb[2], bb[3]);
                lv.x = pk_bf16(a[0] - bflo(hv.x), a[1] - bfhi(hv.x)); lv.y = pk_bf16(a[2] - bflo(hv.y), a[3] - bfhi(hv.y));
                lv.z = pk_bf16(bb[0] - bflo(hv.z), bb[1] - bfhi(hv.z)); lv.w = pk_bf16(bb[2] - bflo(hv.w), bb[3] - bfhi(hv.w));
                qh[ks] = __builtin_bit_cast(bf16x8, hv); ql[ks] = __builtin_bit_cast(bf16x8, lv);
            }
#pragma unroll
            for (int k2 = 0; k2 < 2; ++k2) {
                const int kb = kh2 * 2 + k2;
                f32x16 acc;
#pragma unroll
                for (int i = 0; i < 16; ++i) acc[i] = 0.f;
#pragma unroll
                for (int ks = 0; ks < 4; ++ks) {
                    const size_t off = ((size_t)((h * 2 + c) * 128 + kb * 32 + ln)) * 64 + ks * 16 + hh * 8;
                    const bf16x8 ah = *(const bf16x8*)(KH + off), al = *(const bf16x8*)(KL + off);
                    acc = MFMA32(ah, qh[ks], acc); acc = MFMA32(al, qh[ks], acc); acc = MFMA32(ah, ql[ks], acc);
                }
#pragma unroll
                for (int g = 0; g < 4; ++g) {
                    const int key = kb * 32 + 8 * g + 4 * hh, tokl = ts * 32 + ln;
                    f32x4 v; v[0] = acc[4 * g]; v[1] = acc[4 * g + 1]; v[2] = acc[4 * g + 2]; v[3] = acc[4 * g + 3];
                    *(f32x4*)(sc + (tokl * 2 + c) * SCP + key) = v;
                }
            }
        }
        __syncthreads();
        {
            const int tokl = t >> 3, c = (t >> 2) & 1, qtr = t & 3;
            const float* row = sc + (tokl * 2 + c) * SCP;
            int k32[32];
#pragma unroll
            for (int i4 = 0; i4 < 8; ++i4) {
                const f32x4 v = *(const f32x4*)(row + qtr * 32 + i4 * 4);
#pragma unroll
                for (int j = 0; j < 4; ++j) { const int idx = qtr * 32 + i4 * 4 + j; k32[i4 * 4 + j] = (sortable(v[j]) & ~127) | (127 - idx); }
            }
            bitonic_sort_desc<32>(k32);
            int k[16];
#pragma unroll
            for (int j = 0; j < 16; ++j) k[j] = k32[j];
#pragma unroll
            for (int rnd = 1; rnd <= 2; rnd <<= 1) {
                int o[16];
#pragma unroll
                for (int j = 0; j < 16; ++j) o[j] = __shfl_xor(k[j], rnd);
                merge_top16(k, o);
            }
#pragma unroll
            for (int q = 0; q < 4; ++q)
                if (qtr == q) {
#pragma unroll
                    for (int jj = 0; jj < 4; ++jj) { const int j = q * 4 + jj, idx = 127 - (k[j] & 127); lidx[(tokl * 2 + c) * 16 + j] = idx; lval[(tokl * 2 + c) * 16 + j] = row[idx]; }
                }
        }
        __syncthreads();
        if (t < 256) {
            const int tokl = t >> 2, part = t & 3;
            const float* l0 = lval + (tokl * 2) * 16; const float* l1 = l0 + 16;
            int k[16];
#pragma unroll
            for (int j = 0; j < 16; ++j) {
                const unsigned cj = PEER_CAND[part * 16 + j];
                const int i0 = (cj >> 4) & 15, j0 = cj & 15;
                const int key = (sortable(l0[i0] + l1[j0]) & ~255) | (255 - (i0 * 16 + j0));
                k[j] = cj == 0xffu ? (int)0x80000000 : key;
            }
            bitonic_sort_desc<16>(k);
#pragma unroll
            for (int rnd = 1; rnd <= 2; rnd <<= 1) {
                int o[16];
#pragma unroll
                for (int j = 0; j < 16; ++j) o[j] = __shfl_xor(k[j], rnd);
                merge_top16(k, o);
            }
            const int* i0p = lidx + (tokl * 2) * 16; const int* i1p = i0p + 16;
            float ts_[16]; int e_[16]; float mx = -1e30f;
#pragma unroll
            for (int j = 0; j < 16; ++j) {
                const int pos = 255 - (k[j] & 255), i0 = pos >> 4, j0 = pos & 15;
                ts_[j] = l0[i0] + l1[j0];
                e_[j] = i0p[i0] * 128 + i1p[j0];
                mx = fmaxf(mx, ts_[j]);
            }
            float sum = 0.f;
#pragma unroll
            for (int j = 0; j < 16; ++j) { ts_[j] = __expf(ts_[j] - mx); sum += ts_[j]; }
            const float inv = 1.f / sum;
            const size_t ob = (size_t)(t0 + tokl) * 128 + h * 16;
#pragma unroll
            for (int q = 0; q < 4; ++q)
                if (part == q) {
                    *(int4*)(EIDX + ob + q * 4) = make_int4(e_[q * 4], e_[q * 4 + 1], e_[q * 4 + 2], e_[q * 4 + 3]);
                    f32x4 g; g[0] = ts_[q * 4] * inv; g[1] = ts_[q * 4 + 1] * inv; g[2] = ts_[q * 4 + 2] * inv; g[3] = ts_[q * 4 + 3] * inv;
                    *(f32x4*)(GW + ob + q * 4) = g;
                }
        }
        __syncthreads();
    }
}

DI unsigned xcc_id() { return (unsigned)__builtin_amdgcn_s_getreg((3 << 11) | 20) & 7u; }
#define FP8_PAIRS(q, P) f32x2 P[8]; { _Pragma("unroll") for (int i_ = 0; i_ < 4; ++i_) { P[2 * i_] = __builtin_amdgcn_cvt_pk_f32_fp8((int)q[i_], false); P[2 * i_ + 1] = __builtin_amdgcn_cvt_pk_f32_fp8((int)q[i_], true); } }
constexpr int PEER_CHUNK = 256;

DI void phase_peer_u(const Params& p, unsigned char* smem, int rep) {
    const unsigned char* EU = p.ws + WS_EU; const bf16_t* X2B = (const bf16_t*)(p.ws + WS_XB);
    const int* EIDX = (const int*)(p.ws + WS_EIDX); bf16_t* PD = (bf16_t*)(p.ws + WS_PB);
    unsigned* q = (unsigned*)(p.ws + WS_CTL) + 72 + 16 * rep;
    const int lane = threadIdx.x & 63, w = threadIdx.x >> 6, sub = lane & 7, grp = lane >> 3;
    int* s_item = (int*)smem;
    const int x0 = (int)xcc_id();
    constexpr int NT = PEER_CHUNK / 8;
    for (int xs = 0; xs < 8; ++xs) {
        const int x = (x0 + xs) & 7;
        const unsigned char* EUx = EU + x * 128;
        const unsigned lane_off = (unsigned)sub * 16u;
        for (;;) {
            if (threadIdx.x == 0) s_item[0] = (int)atomicAdd(q + x, 1u);
            __syncthreads();
            const int item = s_item[0];
            __syncthreads();
            if (item >= T / PEER_CHUNK) break;
            const int tok0 = item * PEER_CHUNK + w;
#define U_IDX(n, lo, hi) { const int tk_ = tok0 + 8 * ((n) < NT ? (n) : NT - 1); lo = EIDX[(size_t)tk_ * 128 + lane]; hi = EIDX[(size_t)tk_ * 128 + 64 + lane]; }
#define U_TBL(n, lo, hi, tq, xv) { _Pragma("unroll") for (int i = 0; i < 16; ++i) { const int e = __shfl(i < 8 ? lo : hi, (i * 8 + grp) & 63); tq[i] = *(const u32x4*)(EUx + (((unsigned)e << 10) + lane_off)); } \
                const bf16_t* xp_ = X2B + (size_t)(tok0 + 8 * ((n) < NT ? (n) : NT - 1)) * 1024 + x * 128 + sub * 16; \
                _Pragma("unroll") for (int i = 0; i < 2; ++i) { const u32x4 v = *(const u32x4*)(xp_ + i * 8); xv[4 * i] = (f32x2){bflo(v.x), bfhi(v.x)}; xv[4 * i + 1] = (f32x2){bflo(v.y), bfhi(v.y)}; \
                    xv[4 * i + 2] = (f32x2){bflo(v.z), bfhi(v.z)}; xv[4 * i + 3] = (f32x2){bflo(v.w), bfhi(v.w)}; } }
            int eA_lo, eA_hi, eB_lo, eB_hi;
            u32x4 tqA[16], tqB[16]; f32x2 xvA[8], xvB[8];
            auto consume = [&](const u32x4 (&tq)[16], const f32x2 (&xv)[8], const int n) __attribute__((always_inline)) {
                float dv[16];
#pragma unroll
                for (int i = 0; i < 16; i += 2) {
                    FP8_PAIRS(tq[i], up);
                    FP8_PAIRS(tq[i + 1], uq);
                    f32x2 a0 = up[0] * xv[0], a1 = up[1] * xv[1], b0 = uq[0] * xv[0], b1 = uq[1] * xv[1];
#pragma unroll
                    for (int j = 2; j < 8; j += 2) { a0 = up[j] * xv[j] + a0; a1 = up[j + 1] * xv[j + 1] + a1; b0 = uq[j] * xv[j] + b0; b1 = uq[j + 1] * xv[j + 1] + b1; }
                    a0 += a1; b0 += b1;
                    dv[i] = a0.x + a0.y; dv[i + 1] = b0.x + b0.y;
                }
                float r_lo, r_hi;
                {
                    const bool c0 = sub & 1, c1 = (sub >> 1) & 1, c2 = sub >> 2;
                    float u4[8], u2[4];
#pragma unroll
                    for (int k = 0; k < 8; ++k) { const float keep = c0 ? dv[2 * k + 1] : dv[2 * k], give = c0 ? dv[2 * k] : dv[2 * k + 1]; u4[k] = keep + __shfl_xor(give, 1); }
#pragma unroll
                    for (int k = 0; k < 4; ++k) { const float keep = c1 ? u4[2 * k + 1] : u4[2 * k], give = c1 ? u4[2 * k] : u4[2 * k + 1]; u2[k] = keep + __shfl_xor(give, 2); }
                    { const float keep = c2 ? u2[1] : u2[0], give = c2 ? u2[0] : u2[1]; r_lo = keep + __shfl_xor(give, 4); }
                    { const float keep = c2 ? u2[3] : u2[2], give = c2 ? u2[2] : u2[3]; r_hi = keep + __shfl_xor(give, 4); }
                }
                bf16_t* po = PD + ((size_t)(tok0 + 8 * n) * 8 + x) * 128;
                po[sub * 8 + grp] = f2bf(r_lo); po[64 + sub * 8 + grp] = f2bf(r_hi);
            };
            U_IDX(0, eA_lo, eA_hi);
            U_IDX(1, eB_lo, eB_hi);
            U_TBL(0, eA_lo, eA_hi, tqA, xvA);
            for (int n = 0; n < NT; n += 2) {
                U_TBL(n + 1, eB_lo, eB_hi, tqB, xvB);
                U_IDX(n + 2, eA_lo, eA_hi);
                consume(tqA, xvA, n);
                U_TBL(n + 2, eA_lo, eA_hi, tqA, xvA);
                U_IDX(n + 3, eB_lo, eB_hi);
                consume(tqB, xvB, n + 1);
            }
#undef U_IDX
#undef U_TBL
        }
    }
}

DI void phase_peer_w(const Params& p) {
    const float* SU = (const float*)(p.ws + WS_SU); const float* SV = (const float*)(p.ws + WS_SV);
    const int* EIDX = (const int*)(p.ws + WS_EIDX); float* GW = (float*)(p.ws + WS_GW); const bf16_t* PD = (const bf16_t*)(p.ws + WS_PB);
    for (int i = blockIdx.x * NTHR + threadIdx.x; i < T * 128; i += gridDim.x * NTHR) {
        const int tok = i >> 7, k = i & 127, e = EIDX[i];
        float d = 0.f;
#pragma unroll
        for (int sl = 0; sl < 8; ++sl) d += bf2f(PD[((size_t)tok * 8 + sl) * 128 + k]);
        d *= SU[e];
        GW[i] = GW[i] * 0.5f * d * (1.f + erff(d * 0.70710678118654752f)) * SV[e];
    }
}

DI void phase_peer_v(const Params& p, unsigned char* smem, int rep) {
    const unsigned char* EV = p.ws + WS_EV;
    const int* EIDX = (const int*)(p.ws + WS_EIDX); const float* GW = (const float*)(p.ws + WS_GW);
    unsigned* q = (unsigned*)(p.ws + WS_CTL) + 80 + 16 * rep;
    const int lane = threadIdx.x & 63, w = threadIdx.x >> 6, sub = lane & 7, grp = lane >> 3;
    int* s_item = (int*)smem;
    const int x0 = (int)xcc_id();
    constexpr int NT = PEER_CHUNK / 8;
    const bool b0 = grp & 1, b1 = (grp >> 1) & 1, b2 = grp >> 2;
    for (int xs = 0; xs < 8; ++xs) {
        const int x = (x0 + xs) & 7;
        const unsigned char* EVx = EV + x * 128;
        const unsigned lane_off = (unsigned)sub * 16u;
        for (;;) {
            if (threadIdx.x == 0) s_item[0] = (int)atomicAdd(q + x, 1u);
            __syncthreads();
            const int item = s_item[0];
            __syncthreads();
            if (item >= T / PEER_CHUNK) break;
            const int tok0 = item * PEER_CHUNK + w;
#define V_IDX(n, lo, hi) { const int tk_ = tok0 + 8 * ((n) < NT ? (n) : NT - 1); lo = EIDX[(size_t)tk_ * 128 + lane]; hi = EIDX[(size_t)tk_ * 128 + 64 + lane]; }
#define V_TBL(n, lo, hi, tq, sc) { _Pragma("unroll") for (int i = 0; i < 16; ++i) { const int e = __shfl(i < 8 ? lo : hi, (i * 8 + grp) & 63); tq[i] = *(const u32x4*)(EVx + (((unsigned)e << 10) + lane_off)); } \
                const size_t tk_ = (size_t)(tok0 + 8 * ((n) < NT ? (n) : NT - 1)); sc[0] = GW[tk_ * 128 + lane]; sc[1] = GW[tk_ * 128 + 64 + lane]; }
            int eA_lo, eA_hi, eB_lo, eB_hi;
            u32x4 tqA[16], tqB[16]; float scA[2], scB[2];
            auto consume = [&](const u32x4 (&tq)[16], const float (&sc)[2], const int n) __attribute__((always_inline)) {
                f32x2 acc[8];
#pragma unroll
                for (int j = 0; j < 8; ++j) acc[j] = (f32x2){0.f, 0.f};
#pragma unroll
                for (int i = 0; i < 16; ++i) {
                    const float we = __shfl(i < 8 ? sc[0] : sc[1], (i * 8 + grp) & 63);
                    FP8_PAIRS(tq[i], vp);
                    const f32x2 w2 = (f32x2){we, we};
#pragma unroll
                    for (int j = 0; j < 8; ++j) acc[j] = vp[j] * w2 + acc[j];
                }
                f32x2 r4[4], r2[2], r1;
#pragma unroll
                for (int j = 0; j < 4; ++j) { const f32x2 keep = b0 ? acc[4 + j] : acc[j], give = b0 ? acc[j] : acc[4 + j];
                    r4[j].x = keep.x + __shfl_xor(give.x, 8); r4[j].y = keep.y + __shfl_xor(give.y, 8); }
#pragma unroll
                for (int j = 0; j < 2; ++j) { const f32x2 keep = b1 ? r4[2 + j] : r4[j], give = b1 ? r4[j] : r4[2 + j];
                    r2[j].x = keep.x + __shfl_xor(give.x, 16); r2[j].y = keep.y + __shfl_xor(give.y, 16); }
                { const f32x2 keep = b2 ? r2[1] : r2[0], give = b2 ? r2[0] : r2[1];
                    r1.x = keep.x + __shfl_xor(give.x, 32); r1.y = keep.y + __shfl_xor(give.y, 32); }
                *(unsigned*)((bf16_t*)(p.ws + WS_PB) + (size_t)(tok0 + 8 * n) * 1024 + x * 128 + sub * 16 + 8 * (int)b0 + 4 * (int)b1 + 2 * (int)b2) = pk_bf16(r1.x, r1.y);
            };
            V_IDX(0, eA_lo, eA_hi);
            V_IDX(1, eB_lo, eB_hi);
            V_TBL(0, eA_lo, eA_hi, tqA, scA);
            for (int n = 0; n < NT; n += 2) {
                V_TBL(n + 1, eB_lo, eB_hi, tqB, scB);
                V_IDX(n + 2, eA_lo, eA_hi);
                consume(tqA, scA, n);
                V_TBL(n + 2, eA_lo, eA_hi, tqA, scA);
                V_IDX(n + 3, eB_lo, eB_hi);
                consume(tqB, scB, n + 1);
            }
#undef V_IDX
#undef V_TBL
        }
    }
}

DI void phase_ln3(const Params& p) {
    const bf16_t* X2B = (const bf16_t*)(p.ws + WS_XB);
    const float* g3 = p.in[I_LN3G]; const float* b3 = p.in[I_LN3B];
    const int lane = threadIdx.x & 63, w = threadIdx.x >> 6;
    for (int row = blockIdx.x * 8 + w; row < T; row += gridDim.x * 8) {
        float* yr = p.out + (size_t)row * 1024; const bf16_t* ys = (const bf16_t*)(p.ws + WS_PB) + (size_t)row * 1024; const bf16_t* xr = X2B + (size_t)row * 1024;
        f32x4 v[4]; float s = 0.f;
#pragma unroll
        for (int i = 0; i < 4; ++i) { const u32x2 ab = *(const u32x2*)(xr + i * 256 + lane * 4); f32x4 a; a[0] = bflo(ab.x); a[1] = bfhi(ab.x); a[2] = bflo(ab.y); a[3] = bfhi(ab.y); const u32x2 yb = *(const u32x2*)(ys + i * 256 + lane * 4); f32x4 y; y[0] = bflo(yb.x); y[1] = bfhi(yb.x); y[2] = bflo(yb.y); y[3] = bfhi(yb.y);
#pragma unroll
            for (int j = 0; j < 4; ++j) { v[i][j] = DN_ALPHA * a[j] + y[j]; s += v[i][j]; } }
#pragma unroll
        for (int o = 32; o >= 1; o >>= 1) s += __shfl_xor(s, o);
        const float mu = s * (1.f / 1024.f); float q = 0.f;
#pragma unroll
        for (int i = 0; i < 4; ++i)
#pragma unroll
            for (int j = 0; j < 4; ++j) { const float d = v[i][j] - mu; q += d * d; }
#pragma unroll
        for (int o = 32; o >= 1; o >>= 1) q += __shfl_xor(q, o);
        const float rs = rsqrtf(q * (1.f / 1024.f) + LN_EPS);
#pragma unroll
        for (int i = 0; i < 4; ++i) {
            const int c = i * 256 + lane * 4;
            const f32x4 gg = *(const f32x4*)(g3 + c), bb = *(const f32x4*)(b3 + c);
            f32x4 y;
#pragma unroll
            for (int j = 0; j < 4; ++j) y[j] = (v[i][j] - mu) * rs * gg[j] + bb[j];
            *(f32x4*)(yr + c) = y;
        }
    }
}

DI void run_phase(const Params& p, int ph, unsigned char* smem, int rep) {
    unsigned char* ws = p.ws;
    bf16_t* XS = (bf16_t*)(ws + WS_KB);
    switch (ph) {
    case 0: phase_prep(p, smem); break;
    case 1: phase_inproj(p, smem); break;
    case 2: break;
    case 3: if (rep == 0) phase_mix_a(p);
            phase_mix(p, smem, rep); break;
    case 4: phase_gemm1024<3>((const bf16_t*)(ws + WS_POOL), (const bf16_t*)(ws + WS_WCT), 512, nullptr, nullptr, (bf16_t*)(ws + WS_QB), (const bf16_t*)(ws + WS_EU), 1.f, smem);
            __syncthreads();
            phase_gemm1024<4>((const bf16_t*)(ws + WS_XB), (const bf16_t*)(ws + WS_WBAT), 1024, nullptr, nullptr, (bf16_t*)(ws + WS_QB), (const bf16_t*)(ws + WS_EV), 1.f, smem); break;
    case 5: break;
    case 6: phase_gemm1024<0>((const bf16_t*)(ws + WS_QB), (const bf16_t*)(ws + WS_WOUTT), 1024, p.in[I_X], nullptr, XS, nullptr, 1.f, smem); break;
    case 7: phase_ln(XS, p.in[I_LN1G], p.in[I_LN1B], (bf16_t*)(ws + WS_XB)); break;
    case 8: { phase_gemm1024<1>((const bf16_t*)(ws + WS_XB), (const bf16_t*)(ws + WS_WCQT), 1024, nullptr, nullptr, (bf16_t*)(ws + WS_QB), nullptr, 0.0625f * LOG2E, smem);
              pg8::StaticOrder so; so.init(T, 1024, (int)gridDim.x, (int)blockIdx.x); pg8::Unit un;
              __syncthreads();
              if (so.next(0, un)) phase_xattn(p, smem, un.pm, un.pn); } break;
    case 9: break;
    case 10: phase_gemm1024<5>((const bf16_t*)(ws + WS_PB), (const bf16_t*)(ws + WS_WCOT), 1024, nullptr, nullptr, XS, (const bf16_t*)(ws + WS_XB), 1.f, smem); break;
    case 11: phase_ln(XS, p.in[I_LN2G], p.in[I_LN2B], (bf16_t*)(ws + WS_XB));
             cvt_rows_fp8(p.in[I_EU], ws + WS_EU, (float*)(ws + WS_SU)); cvt_rows_fp8(p.in[I_EV], ws + WS_EV, (float*)(ws + WS_SV)); break;
    case 12: { phase_gemm1024<2>((const bf16_t*)(ws + WS_XB), (const bf16_t*)(ws + WS_WPQT), 1024, nullptr, (float*)(ws + WS_PB), nullptr, nullptr, 1.f, smem);
               pg8::StaticOrder so; so.init(T, 1024, (int)gridDim.x, (int)blockIdx.x); pg8::Unit un;
               __syncthreads();
               if (so.next(0, un)) phase_route(p, smem, un.pm, un.pn); } break;
    case 13: break;
    case 14: phase_peer_u(p, smem, rep); break;
    case 15: phase_peer_w(p); break;
    case 16: phase_peer_v(p, smem, rep); break;
    case 17: phase_ln3(p); break;
    default: break;
    }
}

__global__ void __launch_bounds__(NTHR) fwd_megakernel(Params p) {
    extern __shared__ __attribute__((aligned(16))) unsigned char smem[];
    unsigned* bar = (unsigned*)(p.ws + WS_CTL + 16384);
    __shared__ uint4 xb_words;
    if (threadIdx.x == 0) xb_words = make_uint4(0u, 0u, 0u, 0u);
    __syncthreads();
    const XcdBarrier xb = xcd_barrier_post(bar, (volatile LAS unsigned*)&xb_words);
#define RUN_PH(n) if (p.ph_lo <= (n) && (n) < p.ph_hi) { for (int rep = 0; rep < ((n) == PROBE_DUP ? 2 : 1); ++rep) { run_phase(p, (n), smem, rep); \
        if ((n) + 1 < p.ph_hi || rep + 1 < ((n) == PROBE_DUP ? 2 : 1)) { if (p.use_cg) cg::this_grid().sync(); else xcd_barrier(xb); } } }
    RUN_PH(0) RUN_PH(1) RUN_PH(3) RUN_PH(4) RUN_PH(6) RUN_PH(7) RUN_PH(8) RUN_PH(10) RUN_PH(11) RUN_PH(12) RUN_PH(14) RUN_PH(15) RUN_PH(16) RUN_PH(17)
#undef RUN_PH
}

extern "C" void kernel_launch(void* const* d_in, const int* in_sizes, int n_in, void* d_out, int out_size, void* d_ws, size_t ws_size, hipStream_t stream) {
    static int grid = 0;
    if (grid == 0) {
        int dev = 0, cus = 0, per_cu = 0;
        hipGetDevice(&dev);
        hipDeviceGetAttribute(&cus, hipDeviceAttributeMultiprocessorCount, dev);
        if (hipFuncSetAttribute((const void*)fwd_megakernel, hipFuncAttributeMaxDynamicSharedMemorySize, LDS_BYTES) != hipSuccess) { fprintf(stderr, "hipFuncSetAttribute failed\n"); grid = -1; return; }
        if (hipOccupancyMaxActiveBlocksPerMultiprocessor(&per_cu, (const void*)fwd_megakernel, NTHR, LDS_BYTES) != hipSuccess || per_cu < 1) { fprintf(stderr, "occupancy query failed (%d)\n", per_cu); per_cu = 1; }
        (void)hipGetLastError();
        grid = cus * 1;
        if (n_in != 26 || ws_size < WS_END) { fprintf(stderr, "kernel_launch: unexpected n_in %d / ws_size %zu\n", n_in, ws_size); grid = -1; return; }
    }
    if (grid < 0) return;
    Params p{};
    for (int i = 0; i < 26; ++i) p.in[i] = (const float*)d_in[i];
    p.out = (float*)d_out; p.ws = (unsigned char*)d_ws; p.use_cg = 0; p.pad = 0;
    hipMemsetAsync((char*)d_ws + WS_CTL, 0, 32768, stream);
#if MK_MULTI
    for (int ph = 0; ph < NPHASE; ++ph) {
        p.ph_lo = ph; p.ph_hi = ph + 1;
        hipLaunchKernelGGL(fwd_megakernel, dim3(grid), dim3(NTHR), LDS_BYTES, stream, p);
    }
#else
    p.ph_lo = 0; p.ph_hi = NPHASE;
    void* args[] = {&p};
    hipError_t e = hipLaunchCooperativeKernel((const void*)fwd_megakernel, dim3(grid), dim3(NTHR), args, LDS_BYTES, stream);
    if (e != hipSuccess) fprintf(stderr, "cooperative launch failed: %s (grid %d)\n", hipGetErrorString(e), grid);
#endif
}
```
